# Optimizing an MI355X kernel written in HIP

```python
import math
import jax, jax.numpy as jnp
from jax import lax
import numpy as np

D_MODEL = 1024
BATCH = 32
SEQ = 256
DEPTH = 4
DEC_BATCH = 8
DEC_SEQ = 1024
PAST_LEN = 512

GRID_W = 64
ROPE_BASE = 10000.0
Q_BLOCK = 128
EPS = 1e-6
N_EVEN = (DEPTH + 1) // 2
N_ODD = DEPTH // 2
H_A = 4
DK_A = 64
DV_A = 128
GLA_LR = 16
GLA_TAU = 16.0
GLA_CHUNK = 16
H_B = 4
Q_RANK = 256
KV_RANK = 256
NOPE_B = 128
ROPE_B = 64
V_B = 128
MLA_SCALE = (NOPE_B + ROPE_B) ** -0.5
H_C = 8
DH_C = 64
DIFF_SCALE = DH_C ** -0.5
D_FF = 2816
CONV_W = 3
EVEN_SIZES = (H_A * DK_A, H_A * DK_A, H_A * DV_A, H_A * DV_A, GLA_LR, GLA_LR, Q_RANK, KV_RANK, ROPE_B)
IN_EVEN = sum(EVEN_SIZES)
MIX_EVEN = H_A * DV_A + H_B * V_B
MIX_ODD = H_C * 2 * DH_C
IN_ODD = 3 * MIX_ODD

kernel_name = 'hybrid_flow_gla_mla_diffattn_step'


def rmsnorm(x, g):
    xf = x.astype(jnp.float32)
    y = xf * lax.rsqrt(jnp.mean(xf * xf, axis=-1, keepdims=True) + EPS)
    return (y * g.astype(jnp.float32)).astype(x.dtype)


def modulate(h, shift, scale):
    return h * (1.0 + scale) + shift


def rope_angles(rows, rot_dim):
    t = jnp.arange(rows * GRID_W)
    row = (t // GRID_W).astype(jnp.float32)
    col = (t % GRID_W).astype(jnp.float32)
    half = rot_dim // 2
    inv = ROPE_BASE ** (-jnp.arange(0, half, 2, dtype=jnp.float32) / half)
    return row[:, None] * inv, col[:, None] * inv


def _rot_half(x, ang):
    t, q = ang.shape
    shape = (t,) + (1,) * (x.ndim - 3) + (q,)
    cos = jnp.cos(ang).reshape(shape).astype(x.dtype)
    sin = jnp.sin(ang).reshape(shape).astype(x.dtype)
    x1, x2 = x[..., :q], x[..., q:]
    return jnp.concatenate([x1 * cos - x2 * sin, x2 * cos + x1 * sin], axis=-1)


def axial_rope(x, ang):
    ang_row, ang_col = ang
    half = x.shape[-1] // 2
    return jnp.concatenate([_rot_half(x[..., :half], ang_row), _rot_half(x[..., half:], ang_col)], axis=-1)


def map_query_blocks(fn, q):
    b, t = q.shape[:2]
    nb = t // Q_BLOCK
    qb = jnp.moveaxis(q.reshape((b, nb, Q_BLOCK) + q.shape[2:]), 1, 0)
    ob = lax.map(fn, qb)
    return jnp.moveaxis(ob, 0, 1).reshape((b, t) + ob.shape[3:])


def softmax_attend(q, k, v, scale):
    def blk(qb):
        s = jnp.einsum('bqhd,bkhd->bhqk', qb, k).astype(jnp.float32) * scale
        p = jax.nn.softmax(s, axis=-1).astype(v.dtype)
        return jnp.einsum('bhqk,bkhv->bqhv', p, v)
    return map_query_blocks(blk, q)


def diff_attend(q, k, v, lam, scale):
    def blk(qb):
        s = jnp.einsum('bqhnd,bkhnd->bnhqk', qb, k).astype(jnp.float32) * scale
        p = jax.nn.softmax(s, axis=-1)
        a = (p[:, 0] - lam * p[:, 1]).astype(v.dtype)
        return jnp.einsum('bhqk,bkhv->bqhv', a, v)
    return map_query_blocks(blk, q)


def gla_scan(q, k, v, log_a, s0):
    b, t, h, dk = q.shape
    dv = v.shape[-1]
    n = t // GLA_CHUNK
    f32 = jnp.float32

    def chunks(z):
        return z.reshape((b, n, GLA_CHUNK) + z.shape[2:]).astype(f32)

    qc, kc, vc = chunks(q), chunks(k), chunks(v)
    bcum = jnp.cumsum(chunks(log_a), axis=2)
    idx = jnp.arange(GLA_CHUNK)
    lower = (idx[:, None] >= idx[None, :])[None, None, :, :, None, None]
    rel = jnp.where(lower, bcum[:, :, :, None] - bcum[:, :, None, :], -jnp.inf)
    scores = jnp.einsum('bnthk,bnshk,bntshk->bntsh', qc, kc, jnp.exp(rel))
    o_intra = jnp.einsum('bntsh,bnshv->bnthv', scores, vc)
    b_last = bcum[:, :, -1]
    q_dec = qc * jnp.exp(bcum)
    k_dec = kc * jnp.exp(b_last[:, :, None] - bcum)

    def step(state, inp):
        qd, kd, vv, bl = inp
        o = jnp.einsum('bchk,bhkv->bchv', qd, state)
        state = jnp.exp(bl)[..., None] * state + jnp.einsum('bchk,bchv->bhkv', kd, vv)
        return state, o

    def lead(z):
        return jnp.moveaxis(z, 1, 0)

    s_fin, o_inter = lax.scan(step, s0.astype(f32), (lead(q_dec), lead(k_dec), lead(vc), lead(b_last)))
    o = o_intra + jnp.moveaxis(o_inter, 0, 1)
    return o.reshape(b, t, h, dv).astype(v.dtype), s_fin


def even_project(h, w_in, w_dec, b_dec, q_norm, kv_norm, w_uq):
    b, t = h.shape[:2]
    split_at = np.cumsum(EVEN_SIZES)[:-1].tolist()
    qa, ka, va, ga, lr_f, lr_b, cq, ckv, kr = jnp.split(h @ w_in, split_at, axis=-1)
    qa = qa.reshape(b, t, H_A, DK_A) * (DK_A ** -0.5)
    ka = ka.reshape(b, t, H_A, DK_A)
    va = va.reshape(b, t, H_A, DV_A)
    la_f = jax.nn.log_sigmoid((lr_f @ w_dec[0] + b_dec[0]).astype(jnp.float32)).reshape(b, t, H_A, DK_A) / GLA_TAU
    la_b = jax.nn.log_sigmoid((lr_b @ w_dec[1] + b_dec[1]).astype(jnp.float32)).reshape(b, t, H_A, DK_A) / GLA_TAU
    qb = (rmsnorm(cq, q_norm) @ w_uq).reshape(b, t, H_B, NOPE_B + ROPE_B)
    ckv = rmsnorm(ckv, kv_norm)
    return qa, ka, va, ga, la_f, la_b, qb, ckv, kr


def mla_expand(ckv, kr, w_ukv):
    b, s = ckv.shape[:2]
    kv = (ckv @ w_ukv).reshape(b, s, H_B, NOPE_B + V_B)
    k_nope, v = kv[..., :NOPE_B], kv[..., NOPE_B:]
    k = jnp.concatenate([k_nope, jnp.broadcast_to(kr[:, :, None, :], (b, s, H_B, ROPE_B))], axis=-1)
    return k, v


def gla_output(o_f, o_b_rev, ga, gla_gain):
    b, t = o_f.shape[:2]
    o = o_f + jnp.flip(o_b_rev, axis=1)
    o = rmsnorm(o, gla_gain) * jax.nn.silu(ga.reshape(b, t, H_A, DV_A))
    return o.reshape(b, t, H_A * DV_A)


def even_mixer_context(h, w_in, w_out, w_dec, b_dec, gla_gain, q_norm, kv_norm, w_uq, w_ukv):
    b, t = h.shape[:2]
    qa, ka, va, ga, la_f, la_b, qb, ckv, kr = even_project(h, w_in, w_dec, b_dec, q_norm, kv_norm, w_uq)
    s0 = jnp.zeros((b, H_A, DK_A, DV_A), jnp.float32)
    o_f, s_f = gla_scan(qa, ka, va, la_f, s0)
    fl = lambda z: jnp.flip(z, axis=1)
    o_b, s_b = gla_scan(fl(qa), fl(ka), fl(va), fl(la_b), s0)
    o_gla = gla_output(o_f, o_b, ga, gla_gain)
    k, v = mla_expand(ckv, kr, w_ukv)
    o_mla = softmax_attend(qb, k, v, MLA_SCALE).reshape(b, t, H_B * V_B)
    out = jnp.concatenate([o_gla, o_mla], axis=-1) @ w_out
    return out, jnp.stack([s_f, s_b], axis=1), ckv, kr


def even_mixer_latent(h, st_gla, ckv_ctx, kr_ctx, ang, w_in, w_out, w_dec, b_dec, gla_gain, q_norm, kv_norm, w_uq, w_ukv):
    b, t = h.shape[:2]
    qa, ka, va, ga, la_f, la_b, qb, ckv, kr = even_project(h, w_in, w_dec, b_dec, q_norm, kv_norm, w_uq)
    o_f, _ = gla_scan(qa, ka, va, la_f, st_gla[:, 0])
    fl = lambda z: jnp.flip(z, axis=1)
    o_b, _ = gla_scan(fl(qa), fl(ka), fl(va), fl(la_b), st_gla[:, 1])
    o_gla = gla_output(o_f, o_b, ga, gla_gain)
    qb = jnp.concatenate([qb[..., :NOPE_B], axial_rope(qb[..., NOPE_B:], ang)], axis=-1)
    k_lat, v_lat = mla_expand(ckv, axial_rope(kr, ang), w_ukv)
    k_ctx, v_ctx = mla_expand(ckv_ctx, kr_ctx, w_ukv)
    k = jnp.concatenate([k_ctx, k_lat], axis=1)
    v = jnp.concatenate([v_ctx, v_lat], axis=1)
    o_mla = softmax_attend(qb, k, v, MLA_SCALE).reshape(b, t, H_B * V_B)
    return jnp.concatenate([o_gla, o_mla], axis=-1) @ w_out


def diff_lambda_value(lam_p, lam_init):
    lp = lam_p.astype(jnp.float32)
    return jnp.exp(jnp.sum(lp[0] * lp[1])) - jnp.exp(jnp.sum(lp[2] * lp[3])) + lam_init


def diff_project(h, w_in):
    b, t = h.shape[:2]
    q, k, v = jnp.split(h @ w_in, 3, axis=-1)
    return (q.reshape(b, t, H_C, 2, DH_C), k.reshape(b, t, H_C, 2, DH_C), v.reshape(b, t, H_C, 2 * DH_C))


def diff_output(o, w_out, d_gain, lam_init):
    b, t = o.shape[:2]
    o = rmsnorm(o, d_gain) * (1.0 - lam_init)
    return o.reshape(b, t, MIX_ODD) @ w_out


def diff_mixer_context(h, w_in, w_out, d_gain, lam, lam_init):
    b, t = h.shape[:2]
    q, k, v = diff_project(h, w_in)
    o = diff_attend(q, k, v, lam, DIFF_SCALE)
    return diff_output(o, w_out, d_gain, lam_init), k.reshape(b, t, H_C, 2 * DH_C), v


def diff_mixer_latent(h, k_ctx, v_ctx, ang, w_in, w_out, d_gain, lam, lam_init):
    b = h.shape[0]
    s = k_ctx.shape[1]
    q, k, v = diff_project(h, w_in)
    q = axial_rope(q, ang)
    k = axial_rope(k, ang)
    k_all = jnp.concatenate([k_ctx.reshape(b, s, H_C, 2, DH_C), k], axis=1)
    v_all = jnp.concatenate([v_ctx, v], axis=1)
    o = diff_attend(q, k_all, v_all, lam, DIFF_SCALE)
    return diff_output(o, w_out, d_gain, lam_init)


def conv_ffn(h, w_up, conv_w, conv_b, w_down):
    u = h @ w_up
    p = jnp.pad(u, ((0, 0), (1, 1), (0, 0)))
    u = p[:, :-2] * conv_w[0] + p[:, 1:-1] * conv_w[1] + p[:, 2:] * conv_w[2] + conv_b
    a, g = jnp.split(u, 2, axis=-1)
    return (jax.nn.silu(a) * g) @ w_down


def setup_inputs(seed: int = 0) -> dict:
    key = jax.random.key(seed)
    ks = iter(jax.random.split(key, 32))

    def nrm(shape, scale):
        return jax.random.normal(next(ks), shape, jnp.float32) * scale

    def gain(shape):
        return 1.0 + nrm(shape, 0.05)

    return {
        'x_prompt': nrm((BATCH, SEQ, D_MODEL), 1.0),
        'x_sample': nrm((DEC_BATCH, DEC_SEQ, D_MODEL), 1.0),
        'state_gla': nrm((DEC_BATCH, N_EVEN, 2, H_A, DK_A, DV_A), 1.0),
        'cache_mla_ckv': nrm((DEC_BATCH, N_EVEN, PAST_LEN, KV_RANK), 1.0),
        'cache_mla_krope': nrm((DEC_BATCH, N_EVEN, PAST_LEN, ROPE_B), 1.0),
        'cache_diff_k': nrm((DEC_BATCH, N_ODD, PAST_LEN, H_C, 2 * DH_C), 1.0),
        'cache_diff_v': nrm((DEC_BATCH, N_ODD, PAST_LEN, H_C, 2 * DH_C), 1.0),
        'c': nrm((DEC_BATCH, D_MODEL), 1.0),
        'c_ctx': nrm((D_MODEL,), 1.0),
        'w_ada': nrm((DEPTH, D_MODEL, 6 * D_MODEL), 0.5 * D_MODEL ** -0.5),
        'b_ada': nrm((DEPTH, 6 * D_MODEL), 0.02),
        'norm_gain': gain((DEPTH, 2, D_MODEL)),
        'final_gain': gain((D_MODEL,)),
        'w_in_even': nrm((N_EVEN, D_MODEL, IN_EVEN), D_MODEL ** -0.5),
        'w_out_even': nrm((N_EVEN, MIX_EVEN, D_MODEL), MIX_EVEN ** -0.5),
        'gla_w_decay': nrm((N_EVEN, 2, GLA_LR, H_A * DK_A), GLA_LR ** -0.5),
        'gla_b_decay': nrm((N_EVEN, 2, H_A * DK_A), 0.1),
        'gla_norm': gain((N_EVEN, DV_A)),
        'mla_q_norm': gain((N_EVEN, Q_RANK)),
        'mla_kv_norm': gain((N_EVEN, KV_RANK)),
        'mla_w_uq': nrm((N_EVEN, Q_RANK, H_B * (NOPE_B + ROPE_B)), Q_RANK ** -0.5),
        'mla_w_ukv': nrm((N_EVEN, KV_RANK, H_B * (NOPE_B + V_B)), KV_RANK ** -0.5),
        'w_in_odd': nrm((N_ODD, D_MODEL, IN_ODD), D_MODEL ** -0.5),
        'w_out_odd': nrm((N_ODD, MIX_ODD, D_MODEL), MIX_ODD ** -0.5),
        'diff_lambda': nrm((N_ODD, 4, DH_C), 0.1),
        'diff_norm': gain((N_ODD, 2 * DH_C)),
        'ffn_w_up': nrm((DEPTH, D_MODEL, 2 * D_FF), D_MODEL ** -0.5),
        'ffn_conv_w': nrm((DEPTH, CONV_W, 2 * D_FF), CONV_W ** -0.5),
        'ffn_conv_b': nrm((DEPTH, 2 * D_FF), 0.02),
        'ffn_w_down': nrm((DEPTH, D_FF, D_MODEL), D_FF ** -0.5),
    }


def reference(x_prompt, x_sample, state_gla, cache_mla_ckv, cache_mla_krope, cache_diff_k, cache_diff_v, c,
              c_ctx, w_ada, b_ada, norm_gain, final_gain, w_in_even, w_out_even, gla_w_decay, gla_b_decay,
              gla_norm, mla_q_norm, mla_kv_norm, mla_w_uq, mla_w_ukv, w_in_odd, w_out_odd, diff_lambda,
              diff_norm, ffn_w_up, ffn_conv_w, ffn_conv_b, ffn_w_down):
    rows = x_sample.shape[1] // GRID_W
    ang_b = rope_angles(rows, ROPE_B)
    ang_c = rope_angles(rows, DH_C)
    s_ctx = jax.nn.silu(c_ctx)[None, :]
    s_lat = jax.nn.silu(c)
    xp, xs = x_prompt, x_sample
    gla_states, mla_ckvs, mla_krs, diff_ks, diff_vs = [], [], [], [], []
    for l in range(DEPTH):
        mp = jnp.split((s_ctx @ w_ada[l] + b_ada[l])[:, None, :], 6, axis=-1)
        ms = jnp.split((s_lat @ w_ada[l] + b_ada[l])[:, None, :], 6, axis=-1)
        hp = modulate(rmsnorm(xp, norm_gain[l, 0]), mp[0], mp[1])
        hs = modulate(rmsnorm(xs, norm_gain[l, 0]), ms[0], ms[1])
        i = l // 2
        if l % 2 == 0:
            ep = (w_in_even[i], w_out_even[i], gla_w_decay[i], gla_b_decay[i], gla_norm[i],
                  mla_q_norm[i], mla_kv_norm[i], mla_w_uq[i], mla_w_ukv[i])
            op, st, ckv, kr = even_mixer_context(hp, *ep)
            os_ = even_mixer_latent(hs, state_gla[:, i], cache_mla_ckv[:, i], cache_mla_krope[:, i], ang_b, *ep)
            gla_states.append(st)
            mla_ckvs.append(ckv)
            mla_krs.append(kr)
        else:
            lam_init = 0.8 - 0.6 * math.exp(-0.3 * l)
            lam = diff_lambda_value(diff_lambda[i], lam_init)
            op, k_new, v_new = diff_mixer_context(hp, w_in_odd[i], w_out_odd[i], diff_norm[i], lam, lam_init)
            os_ = diff_mixer_latent(hs, cache_diff_k[:, i], cache_diff_v[:, i], ang_c, w_in_odd[i], w_out_odd[i],
                                    diff_norm[i], lam, lam_init)
            diff_ks.append(k_new)
            diff_vs.append(v_new)
        xp = xp + mp[2] * op
        xs = xs + ms[2] * os_
        hp = modulate(rmsnorm(xp, norm_gain[l, 1]), mp[3], mp[4])
        hs = modulate(rmsnorm(xs, norm_gain[l, 1]), ms[3], ms[4])
        xp = xp + mp[5] * conv_ffn(hp, ffn_w_up[l], ffn_conv_w[l], ffn_conv_b[l], ffn_w_down[l])
        xs = xs + ms[5] * conv_ffn(hs, ffn_w_up[l], ffn_conv_w[l], ffn_conv_b[l], ffn_w_down[l])
    y_prompt = rmsnorm(xp, final_gain)
    y_sample = rmsnorm(xs, final_gain)
    return (y_prompt, y_sample, jnp.stack(gla_states, axis=1), jnp.stack(mla_ckvs, axis=1),
            jnp.stack(mla_krs, axis=1), jnp.stack(diff_ks, axis=1), jnp.stack(diff_vs, axis=1))
```

```cpp
#include <hip/hip_runtime.h>
#include <cstdio>
#include <cstdint>
#include <cmath>
namespace pg8 {
#define PG8_LAS __attribute__((address_space(3)))
typedef unsigned short bf16_t;
typedef short bf16x8 __attribute__((ext_vector_type(8)));
typedef float f32x4 __attribute__((ext_vector_type(4)));
typedef unsigned u32x4 __attribute__((ext_vector_type(4)));
constexpr int BM = 256, BK = 64, HALF = 128, HTB = HALF * BK * 2  , STAGE_BYTES = 8 * HTB, NXCD = 8, WGM = 8;

__host__ __device__ __forceinline__ int lds_byte(int r, int c) { const int st = (r >> 4) * 2 + (c >> 5), rr = r & 15, cc = c & 31, ob = rr * 64 + cc * 2; return st * 1024 + (ob ^ (((ob >> 9) & 1) << 5)); }
__host__ __device__ __forceinline__ void stage_rc(int b, int& R, int& C) { const int st = b / 1024, sb = b % 1024, swz = sb ^ (((sb >> 9) & 1) << 5); R = (st >> 1) * 16 + swz / 64; C = (st & 1) * 32 + (swz % 64) / 2; }
__host__ __device__ __forceinline__ int perm32(int rho) { const int n = rho >> 4, i = rho & 15; return 8 * (i >> 2) + 4 * n + (i & 3); }

struct Unit { int pm, pn, idx; };
struct Gemm { const bf16_t* A; const bf16_t* Bt; int M, N, K, lda, ldb; };

struct StaticOrder {
    int nM, nN, nwg, G, c;
    __host__ __device__ __forceinline__ void init(int M, int N, int G_, int c_) { nM = M / BM; nN = N / BM; nwg = nM * nN; G = G_; c = c_; }
    __host__ __device__ __forceinline__ bool next(int i, Unit& u) const {
        if (c < 0) return false;
        const long L = (long)i * G + c; if (L >= nwg) return false;
        int wgid = (int)L; { const int q = nwg / NXCD, r = nwg % NXCD, xcd = wgid % NXCD, off = wgid / NXCD; wgid = (xcd < r ? xcd * (q + 1) : r * (q + 1) + (xcd - r) * q) + off; }
        const int nig = WGM * nN, gid = wgid / nig, fm = gid * WGM, gsz = (nM - fm) < WGM ? (nM - fm) : WGM;
        u.pm = fm + ((wgid % nig) % gsz); u.pn = (wgid % nig) / gsz; return true;
    }
    __device__ __forceinline__ void a_ready(const Unit&) const {}
    __device__ __forceinline__ void done(const Unit&) const {}
};

template <class Epi, class Sched, bool ALIGN_EPI = false, bool SP2 = false, int NB = 2>
__device__ __forceinline__ void gemm_phase(PG8_LAS unsigned char* lds, const Gemm g, const Sched& S, const Epi& E) {
    int tid_ = threadIdx.x; asm volatile("" : "+v"(tid_));
    const int tid = tid_, wid = __builtin_amdgcn_readfirstlane(tid >> 6), lane = tid & 63, wr = wid >> 2, wc = wid & 3, fr = lane & 15, fq = lane >> 4;
    const int K = g.K, nt = K / BK;
    unsigned voffA[2], voffB[2];
#pragma unroll
    for (int i = 0; i < 2; ++i) { int R, C; stage_rc(tid * 16 + i * 8192, R, C); const int Rb = Epi::PERM ? ((R & ~31) + perm32(R & 31)) : R;
        const int Ra = Epi::AROWPERM ? (128 * (R >> 6) + 8 * (R & 15) + ((R >> 4) & 3)) : R;
        voffA[i] = (unsigned)(Ra * g.lda + C) * 2u; voffB[i] = (unsigned)(Rb * g.ldb + C) * 2u; }
    const size_t kstep = (size_t)(BK * 2);
    const size_t hstepA = (size_t)(Epi::AROWPERM ? 4 : HALF) * g.lda * 2, hstepB = (size_t)HALF * g.ldb * 2;
    static_assert(NB == 2 || SP2, "NB = 1 is written for the SP2 loop only");
    const size_t tstepA = (size_t)2 * HALF * g.lda * 2, tstepB = NB * hstepB;
    const unsigned ldsw = (unsigned)wid * 1024u;
    const int aoff = lds_byte(wr * 64 + fr, fq * 8), boff = lds_byte(wc * 32 + fr, fq * 8);
#define PG8_SA(b, h) (((b) * 2 + (h)) * HTB)
#define PG8_SB(b, h) ((4 + (b) * 2 + (h)) * HTB)
#define PG8_STAGE(bufoff, gbase, voff) do { _Pragma("unroll") for (int _i = 0; _i < 2; ++_i) \
        __builtin_amdgcn_global_load_lds((const unsigned*)((const char*)(gbase) + (voff)[_i]), (PG8_LAS unsigned*)(lds + (bufoff) + ldsw + _i * 8192), 16, 0, 0); } while (0)
#define PG8_LDA(dst, b, h) do { _Pragma("unroll") for (int m = 0; m < 4; ++m) _Pragma("unroll") for (int k = 0; k < 2; ++k) dst[m][k] = *(const PG8_LAS bf16x8*)(lds + PG8_SA(b, h) + aoff + m * 2048 + k * 1024); } while (0)
#define PG8_LDB(dst, b, h) do { _Pragma("unroll") for (int n = 0; n < 2; ++n) _Pragma("unroll") for (int k = 0; k < 2; ++k) dst[n][k] = *(const PG8_LAS bf16x8*)(lds + PG8_SB(b, h) + boff + n * 2048 + k * 1024); } while (0)
#define PG8_MMA(ai, bj, At, Bt) do { __builtin_amdgcn_s_setprio(1); _Pragma("unroll") for (int m = 0; m < 4; ++m) _Pragma("unroll") for (int n = 0; n < 2; ++n) _Pragma("unroll") for (int k = 0; k < 2; ++k) \
        acc[ai][bj][m][n] = __builtin_amdgcn_mfma_f32_16x16x32_bf16(Bt[n][k], At[m][k], acc[ai][bj][m][n], 0, 0, 0); __builtin_amdgcn_s_setprio(0); } while (0)
#define PG8_WAIT_V(n) asm volatile("s_waitcnt vmcnt(" #n ")" ::: "memory")
#define PG8_WAIT_L(n) asm volatile("s_waitcnt lgkmcnt(" #n ")" ::: "memory")
#define PG8_BAR __builtin_amdgcn_s_barrier()
#define PG8_SCHED __builtin_amdgcn_sched_barrier(0)
    Unit cur, nxt; int ui = 0;
    if (!S.next(0, cur)) return;
    cur.idx = 0;
    f32x4 acc[2][2][4][2];
#pragma unroll
    for (int a = 0; a < 2; ++a)
#pragma unroll
        for (int b = 0; b < 2; ++b)
#pragma unroll
            for (int m = 0; m < 4; ++m)
#pragma unroll
                for (int n = 0; n < 2; ++n) acc[a][b][m][n] = (f32x4){0.f, 0.f, 0.f, 0.f};
    bf16x8 At[4][2], B0[2][2], B1[2][2];
    const char* cA = (const char*)g.A + (size_t)cur.pm * tstepA; const char* cB = (const char*)g.Bt + (size_t)cur.pn * tstepB;
    S.a_ready(cur);
    if constexpr (SP2 && NB == 1) {
        PG8_STAGE(PG8_SB(0, 0), cB, voffB); PG8_STAGE(PG8_SA(0, 0), cA, voffA); PG8_STAGE(PG8_SA(0, 1), cA + hstepA, voffA);
        if (wr == 1) PG8_BAR;
        PG8_WAIT_V(2); PG8_BAR;
        PG8_STAGE(PG8_SB(1, 0), cB + kstep, voffB); PG8_STAGE(PG8_SA(1, 0), cA + kstep, voffA);
        PG8_WAIT_V(4); PG8_BAR;
    } else if constexpr (SP2) {
        PG8_STAGE(PG8_SB(0, 0), cB, voffB); PG8_STAGE(PG8_SB(0, 1), cB + hstepB, voffB); PG8_STAGE(PG8_SA(0, 0), cA, voffA); PG8_STAGE(PG8_SA(0, 1), cA + hstepA, voffA);
        if (wr == 1) PG8_BAR;
        PG8_WAIT_V(2); PG8_BAR;
        PG8_STAGE(PG8_SB(1, 0), cB + kstep, voffB); PG8_STAGE(PG8_SA(1, 0), cA + kstep, voffA); PG8_STAGE(PG8_SB(1, 1), cB + hstepB + kstep, voffB);
        PG8_WAIT_V(6); PG8_BAR;
    } else {
        PG8_STAGE(PG8_SB(0, 0), cB, voffB); PG8_STAGE(PG8_SA(0, 0), cA, voffA); PG8_STAGE(PG8_SB(0, 1), cB + hstepB, voffB); PG8_STAGE(PG8_SA(0, 1), cA + hstepA, voffA);
        if (wr == 1) PG8_BAR;
        PG8_WAIT_V(4); PG8_BAR;
        PG8_STAGE(PG8_SB(1, 0), cB + kstep, voffB); PG8_STAGE(PG8_SA(1, 0), cA + kstep, voffA); PG8_STAGE(PG8_SB(1, 1), cB + hstepB + kstep, voffB);
        PG8_WAIT_V(6); PG8_BAR;
    }
    for (;;) {
        const bool has_next = S.next(ui + 1, nxt); nxt.idx = ui + 1;
        const char* nA = has_next ? (const char*)g.A + (size_t)nxt.pm * tstepA : cA; const char* nB = has_next ? (const char*)g.Bt + (size_t)nxt.pn * tstepB : cB;
        for (int t = 0; t < nt; t += 2) {
            const bool last = (t == nt - 2);
            const char* a1 = cA + (size_t)(t + 1) * kstep;
            const char* a2 = last ? nA : cA + (size_t)(t + 2) * kstep; const char* b2 = last ? nB : cB + (size_t)(t + 2) * kstep;
            const char* a3 = a2 + kstep; const char* b3 = b2 + kstep;
            if (last && has_next) S.a_ready(nxt);
            if constexpr (SP2 && NB == 1) {
            PG8_LDB(B0, 0, 0); PG8_SCHED; PG8_LDA(At, 0, 0); PG8_STAGE(PG8_SA(1, 1), a1 + hstepA, voffA);
            PG8_WAIT_V(6); PG8_WAIT_L(0); PG8_BAR; PG8_MMA(0, 0, At, B0); PG8_BAR; PG8_SCHED;
            PG8_LDA(At, 0, 1); PG8_STAGE(PG8_SB(0, 0), b2, voffB); PG8_STAGE(PG8_SA(0, 0), a2, voffA);
            PG8_WAIT_V(6); PG8_WAIT_L(0); PG8_BAR; PG8_MMA(1, 0, At, B0); PG8_BAR; PG8_SCHED;
            PG8_LDB(B0, 1, 0); PG8_SCHED; PG8_LDA(At, 1, 0); PG8_STAGE(PG8_SA(0, 1), a2 + hstepA, voffA);
            PG8_WAIT_V(6); PG8_WAIT_L(0); PG8_BAR; PG8_MMA(0, 0, At, B0); PG8_BAR; PG8_SCHED;
            PG8_LDA(At, 1, 1); PG8_STAGE(PG8_SB(1, 0), b3, voffB); PG8_STAGE(PG8_SA(1, 0), a3, voffA);
            PG8_WAIT_V(6); PG8_WAIT_L(0); PG8_BAR; PG8_MMA(1, 0, At, B0); PG8_BAR; PG8_SCHED;
            } else if constexpr (SP2) {
            PG8_LDB(B0, 0, 0); PG8_LDB(B1, 0, 1); PG8_SCHED; PG8_LDA(At, 0, 0); PG8_STAGE(PG8_SA(1, 1), a1 + hstepA, voffA);
            PG8_WAIT_V(8); PG8_WAIT_L(0); PG8_BAR; PG8_MMA(0, 0, At, B0); PG8_MMA(0, 1, At, B1); PG8_BAR; PG8_SCHED;
            PG8_LDA(At, 0, 1); PG8_STAGE(PG8_SB(0, 0), b2, voffB); PG8_STAGE(PG8_SB(0, 1), b2 + hstepB, voffB); PG8_STAGE(PG8_SA(0, 0), a2, voffA);
            PG8_WAIT_V(8); PG8_WAIT_L(0); PG8_BAR; PG8_MMA(1, 0, At, B0); PG8_MMA(1, 1, At, B1); PG8_BAR; PG8_SCHED;
            PG8_LDB(B0, 1, 0); PG8_LDB(B1, 1, 1); PG8_SCHED; PG8_LDA(At, 1, 0); PG8_STAGE(PG8_SA(0, 1), a2 + hstepA, voffA);
            PG8_WAIT_V(8); PG8_WAIT_L(0); PG8_BAR; PG8_MMA(0, 0, At, B0); PG8_MMA(0, 1, At, B1); PG8_BAR; PG8_SCHED;
            PG8_LDA(At, 1, 1); PG8_STAGE(PG8_SB(1, 0), b3, voffB); PG8_STAGE(PG8_SB(1, 1), b3 + hstepB, voffB); PG8_STAGE(PG8_SA(1, 0), a3, voffA);
            PG8_WAIT_V(8); PG8_WAIT_L(0); PG8_BAR; PG8_MMA(1, 0, At, B0); PG8_MMA(1, 1, At, B1); PG8_BAR; PG8_SCHED;
            } else {
            PG8_LDB(B0, 0, 0); PG8_SCHED; PG8_LDA(At, 0, 0); PG8_STAGE(PG8_SA(1, 1), a1 + hstepA, voffA);
            PG8_WAIT_L(8); PG8_BAR; PG8_WAIT_L(0); PG8_MMA(0, 0, At, B0); PG8_BAR; PG8_SCHED;
            PG8_LDB(B1, 0, 1); PG8_STAGE(PG8_SB(0, 0), b2, voffB);
            PG8_BAR; PG8_WAIT_L(0); PG8_MMA(0, 1, At, B1); PG8_BAR;
            PG8_LDA(At, 0, 1); PG8_STAGE(PG8_SA(0, 0), a2, voffA);
            PG8_BAR; PG8_WAIT_L(0); PG8_MMA(1, 0, At, B0); PG8_BAR; PG8_SCHED;
            PG8_STAGE(PG8_SB(0, 1), b2 + hstepB, voffB);
            PG8_WAIT_V(6); PG8_BAR; PG8_MMA(1, 1, At, B1); PG8_BAR;
            PG8_LDB(B0, 1, 0); PG8_SCHED; PG8_LDA(At, 1, 0); PG8_STAGE(PG8_SA(0, 1), a2 + hstepA, voffA);
            PG8_WAIT_L(8); PG8_BAR; PG8_WAIT_L(0); PG8_MMA(0, 0, At, B0); PG8_BAR; PG8_SCHED;
            PG8_LDB(B1, 1, 1); PG8_STAGE(PG8_SB(1, 0), b3, voffB);
            PG8_BAR; PG8_WAIT_L(0); PG8_MMA(0, 1, At, B1); PG8_BAR;
            PG8_LDA(At, 1, 1); PG8_STAGE(PG8_SA(1, 0), a3, voffA);
            PG8_BAR; PG8_WAIT_L(0); PG8_MMA(1, 0, At, B0); PG8_BAR; PG8_SCHED;
            PG8_STAGE(PG8_SB(1, 1), b3 + hstepB, voffB);
            PG8_WAIT_V(6); PG8_BAR; PG8_MMA(1, 1, At, B1); PG8_BAR;
            }
        }
        if constexpr (ALIGN_EPI) { if (wr == 0) PG8_BAR; }
        if constexpr (!Epi::AFTER_DRAIN) { E(acc, cur, wr, wc, fr, fq); S.done(cur); }
        if (!has_next) break;
#pragma unroll
        for (int a = 0; a < 2; ++a)
#pragma unroll
            for (int b = 0; b < 2; ++b)
#pragma unroll
                for (int m = 0; m < 4; ++m)
#pragma unroll
                    for (int n = 0; n < 2; ++n) acc[a][b][m][n] = (f32x4){0.f, 0.f, 0.f, 0.f};
        cur = nxt; cA = nA; cB = nB; ++ui;
        if constexpr (ALIGN_EPI) { if (wr == 1) PG8_BAR; }
    }
    PG8_WAIT_V(0);
    if constexpr (!ALIGN_EPI) { if (wr == 0) PG8_BAR; }
    PG8_BAR;
    if constexpr (Epi::AFTER_DRAIN) { E.fused(acc, cur, wr, wc, fr, fq, lds, wid, lane); S.done(cur); }
#undef PG8_SA
#undef PG8_SB
#undef PG8_STAGE
#undef PG8_LDA
#undef PG8_LDB
#undef PG8_MMA
#undef PG8_WAIT_V
#undef PG8_WAIT_L
#undef PG8_BAR
#undef PG8_SCHED
}
}
#define GAS __attribute__((address_space(1)))
#define LAS __attribute__((address_space(3)))
typedef unsigned short bf16;
typedef long long i64;
typedef unsigned v4u __attribute__((ext_vector_type(4)));
typedef unsigned v2u __attribute__((ext_vector_type(2)));
typedef float f32x4 __attribute__((ext_vector_type(4)));
typedef float f32x16 __attribute__((ext_vector_type(16)));
typedef short bf16x8 __attribute__((ext_vector_type(8)));
typedef short s16x4 __attribute__((ext_vector_type(4)));
typedef GAS unsigned gu32;
#define RLX_AGENT __ATOMIC_RELAXED, __HIP_MEMORY_SCOPE_AGENT
#define LDS_WAIT() asm volatile("s_waitcnt lgkmcnt(0)" ::: "memory")
#define VM_WAIT() asm volatile("s_waitcnt vmcnt(0)" ::: "memory")
typedef float f32x2_t __attribute__((ext_vector_type(2))); typedef __bf16 bf16x2_t __attribute__((ext_vector_type(2)));
__device__ __forceinline__ unsigned pk2(float lo, float hi) { const f32x2_t v = {lo, hi}; const bf16x2_t b = __builtin_convertvector(v, bf16x2_t); return __builtin_bit_cast(unsigned, b); }
__device__ __forceinline__ unsigned f2bf(float f) { return pk2(f, 0.f) & 0xffffu; }
__device__ __forceinline__ float bf2f(unsigned short b) { return __builtin_bit_cast(float, (unsigned)b << 16); }
__device__ __forceinline__ float bflo(unsigned w) { return __builtin_bit_cast(float, w << 16); }
__device__ __forceinline__ float bfhi(unsigned w) { return __builtin_bit_cast(float, w & 0xffff0000u); }
__device__ __forceinline__ float silu_f(float x) { return x * __builtin_amdgcn_rcpf(1.f + __builtin_amdgcn_exp2f(-1.4426950408889634f * x)); }
__device__ __forceinline__ float logsigmoid_f(float x) { return fminf(x, 0.f) - 0.6931471805599453f * __builtin_amdgcn_logf(1.f + __builtin_amdgcn_exp2f(-1.4426950408889634f * fabsf(x))); }
__device__ __forceinline__ float ex2(float x) { return __builtin_amdgcn_exp2f(x); }

constexpr int D = 1024, BATCH = 32, SEQ = 256, DEC_BATCH = 8, DEC_SEQ = 1024, PAST = 512, D_FF = 2816;
constexpr int DEPTH = 4, N_EVEN = 2, N_ODD = 2, GRID_W = 64;
constexpr int UP_FULL_N = 5120;
constexpr int H_A = 4, DK_A = 64, DV_A = 128, GLA_LR = 16;
constexpr int H_B = 4, Q_RANK = 256, KV_RANK = 256, NOPE = 128, ROPE = 64, V_B = 128, QB_W = 768, KV_W = 1024;
constexpr int H_C = 8, DH_C = 64;
constexpr int IN_EVEN = 2144, IN_EVEN_P = 2304, MIXW = 1024, IN_ODD = 3072, PBE_W = 2048, PBO_W = 2048;
constexpr float EPS = 1e-6f;
constexpr int NWAVES = 8, NTHR = 512;
constexpr int M_ALL = 16384, M_CTX = 8192, CROWS = DEC_BATCH * PAST;
constexpr float LOG2E = 1.4426950408889634f;
constexpr float MLA_QSCALE = 0.07216878364870322f * LOG2E;
constexpr float DIFF_QSCALE = 0.125f * LOG2E;
constexpr float LOG2_ROPE_BASE = 13.287712379549449f;

constexpr size_t MiB = 1u << 20;
constexpr size_t WS_CTL = 0;
constexpr int CW_BAR = 4096;
constexpr int CW_PAIR = 16384;
constexpr size_t WS_MODS = 1 * MiB;
constexpr size_t ZERO_BYTES = WS_MODS + (size_t)DEPTH * 9 * 6 * D * 4;
constexpr size_t WS_SHW = 2 * MiB;
constexpr size_t WS_GS = WS_SHW + (size_t)DEPTH * 2 * 9 * 2 * D_FF * 4;
constexpr size_t WS_WINE = 4 * MiB;
constexpr size_t WS_WOUTE = WS_WINE + (size_t)2 * IN_EVEN_P * D * 2;
constexpr size_t WS_WUQ = WS_WOUTE + (size_t)2 * D * MIXW * 2;
constexpr size_t WS_WUKV = WS_WUQ + (size_t)2 * QB_W * Q_RANK * 2;
constexpr size_t WS_WUKVC = WS_WUKV + (size_t)2 * KV_W * KV_RANK * 2;
constexpr size_t WS_WINO = WS_WUKVC + (size_t)2 * KV_W * KV_RANK * 2;
constexpr size_t WS_WOUTO = WS_WINO + (size_t)2 * IN_ODD * D * 2;
constexpr size_t WS_WUP = WS_WOUTO + (size_t)2 * D * MIXW * 2;
constexpr size_t WS_WDN = WS_WUP + (size_t)4 * 2 * D_FF * D * 2;
constexpr size_t WS_CCKV = WS_WDN + (size_t)4 * D * D_FF * 2;
constexpr size_t WS_KNC = WS_CCKV + (size_t)2 * CROWS * KV_RANK * 2;
constexpr size_t WS_VTC = WS_KNC + (size_t)2 * CROWS * 512 * 2;
constexpr size_t WS_KRC = WS_VTC + (size_t)2 * CROWS * 512 * 2;
constexpr size_t WS_KDC = WS_KRC + (size_t)2 * CROWS * 64 * 2;
constexpr size_t WS_VDC = WS_KDC + (size_t)2 * CROWS * 1024 * 2;
constexpr size_t WS_X = WS_VDC + (size_t)2 * CROWS * 1024 * 2;
constexpr size_t WS_XG = WS_X + (size_t)M_ALL * D * 2;
constexpr size_t WS_SSQ = WS_XG + (size_t)M_ALL * D * 2;
constexpr size_t WS_MIX = WS_SSQ + (size_t)2 * M_ALL * 16 * 4;
constexpr size_t WS_SCR = WS_MIX + (size_t)M_ALL * MIXW * 2;
constexpr size_t WS_PBE = WS_SCR;
constexpr size_t WS_QBUF = WS_PBE + (size_t)M_ALL * PBE_W * 2;
constexpr size_t WS_KN = WS_QBUF + (size_t)M_ALL * QB_W * 2;
constexpr size_t WS_VT = WS_KN + (size_t)M_ALL * 512 * 2;
constexpr size_t WS_KR = WS_VT + (size_t)M_ALL * 512 * 2;
constexpr size_t WS_LR = WS_KR + (size_t)M_ALL * 64 * 2;
constexpr size_t WS_SSQC = WS_LR + (size_t)M_ALL * 32 * 4;
constexpr size_t WS_OGB = WS_SSQC + (size_t)2 * M_ALL * 4 * 4;
constexpr size_t WS_LD = WS_OGB + (size_t)M_ALL * 512 * 2;
constexpr size_t WS_EVEN_END = WS_LD + (size_t)M_ALL * 512 * 4;
constexpr size_t WS_PBO = WS_SCR;
constexpr size_t WS_VD = WS_PBO + (size_t)M_ALL * PBO_W * 2;
constexpr size_t WS_OD1 = WS_VD + (size_t)M_ALL * 1024 * 2;
constexpr size_t WS_ODD_END = WS_OD1 + (size_t)M_ALL * 1024 * 2;
constexpr size_t WS_ACT = WS_MIX;
constexpr size_t WS_UB = WS_ACT + (size_t)M_ALL * D_FF * 2;
constexpr size_t WS_FFN_END = WS_UB + (size_t)64 * 8 * 2 * D_FF * 4;
constexpr size_t WS_END = (WS_EVEN_END > WS_ODD_END ? (WS_EVEN_END > WS_FFN_END ? WS_EVEN_END : WS_FFN_END) : (WS_ODD_END > WS_FFN_END ? WS_ODD_END : WS_FFN_END));
static_assert(WS_END <= (size_t)451 * 1000 * 1000, "workspace map exceeds the guaranteed d_ws size");
static_assert(ZERO_BYTES <= WS_SHW && WS_GS + (size_t)DEPTH * 2 * 9 * D * 4 <= WS_WINE, "ws head");

constexpr int RING_BYTES = 131072, LDSCTL_OFF = RING_BYTES, MISC_OFF = LDSCTL_OFF + 320, ARGS_OFF = LDSCTL_OFF + 1024, LDS_BYTES = 147456;
constexpr int RS_OFF = ARGS_OFF + 256, RS_UNITS = 6, SH_OFF = RS_OFF + RS_UNITS * 1024;
static_assert(SH_OFF + RS_UNITS * 1024 <= LDS_BYTES, "LDS map");

__device__ __forceinline__ unsigned long long ldsq(LAS unsigned char* lds, int k) {
    volatile LAS unsigned* p = (volatile LAS unsigned*)(lds + ARGS_OFF) + 2 * k;
    const unsigned lo = (unsigned)__builtin_amdgcn_readfirstlane((int)p[0]), hi = (unsigned)__builtin_amdgcn_readfirstlane((int)p[1]);
    return ((unsigned long long)hi << 32) | lo;
}
#define ARGQ(k) ldsq(lds, (k))
template <class T> __device__ __forceinline__ T* gptr(unsigned long long v) { T* p = (T*)v;
#if defined(__HIP_DEVICE_COMPILE__)
    __builtin_assume(!__builtin_amdgcn_is_shared((const __attribute__((address_space(0))) void*)p)); __builtin_assume(!__builtin_amdgcn_is_private((const __attribute__((address_space(0))) void*)p));
#endif
    return p; }
#define IN_F(k) (gptr<const float>(ARGQ(k)))
#define OUTB (gptr<float>(ARGQ(30)))
#define WSB (gptr<unsigned char>(ARGQ(31)))
#define WSP(T, off) ((T*)(WSB + (off)))
#define x_prompt IN_F(0)
#define x_sample IN_F(1)
#define state_gla IN_F(2)
#define cache_mla_ckv IN_F(3)
#define cache_mla_krope IN_F(4)
#define cache_diff_k IN_F(5)
#define cache_diff_v IN_F(6)
#define cvec IN_F(7)
#define c_ctx IN_F(8)
#define w_ada IN_F(9)
#define b_ada IN_F(10)
#define norm_gain IN_F(11)
#define final_gain IN_F(12)
#define w_in_even IN_F(13)
#define w_out_even IN_F(14)
#define gla_w_decay IN_F(15)
#define gla_b_decay IN_F(16)
#define gla_norm IN_F(17)
#define mla_q_norm IN_F(18)
#define mla_kv_norm IN_F(19)
#define mla_w_uq IN_F(20)
#define mla_w_ukv IN_F(21)
#define w_in_odd IN_F(22)
#define w_out_odd IN_F(23)
#define diff_lambda IN_F(24)
#define diff_norm IN_F(25)
#define ffn_w_up IN_F(26)
#define ffn_conv_w IN_F(27)
#define ffn_conv_b IN_F(28)
#define ffn_w_down IN_F(29)
#define o_y_prompt (OUTB)
#define o_y_sample (OUTB + (i64)BATCH * SEQ * D)
#define o_state (o_y_sample + (i64)DEC_BATCH * DEC_SEQ * D)
#define o_ckv (o_state + (i64)BATCH * N_EVEN * 2 * H_A * DK_A * DV_A)
#define o_krope (o_ckv + (i64)BATCH * N_EVEN * SEQ * KV_RANK)
#define o_dk (o_krope + (i64)BATCH * N_EVEN * SEQ * ROPE)
#define o_dv (o_dk + (i64)BATCH * N_ODD * SEQ * 1024)
#define XB_TMO      128
#define XB_XCNT(j)  (256  + 64 * (j))
#define XB_XSUB(j)  (1280 + 64 * (j))
#define XB_XGEN(j)  (2304 + 64 * (j))
#define XB_TOP      3328
#define XB_TOPGEN   3392
#define XCD_BAR_WORDS 3456
#define XB_SPIN_CAP (1u << 18)

__device__ __forceinline__ unsigned xb_ld(unsigned* p)              { return __hip_atomic_load(p, __ATOMIC_RELAXED, __HIP_MEMORY_SCOPE_AGENT); }
__device__ __forceinline__ unsigned xb_add(unsigned* p, unsigned v) { return __hip_atomic_fetch_add(p, v, __ATOMIC_RELAXED, __HIP_MEMORY_SCOPE_AGENT); }
__device__ __forceinline__ unsigned xb_xcc_id() { return (unsigned)__builtin_amdgcn_s_getreg((3 << 11) | 20) & 0xFu; }
#define XB_SPIN(cond, bar) do { unsigned _sp = 0; while (cond) { __builtin_amdgcn_s_sleep(1); \
    if ((++_sp & 255u) == 0u) { if (xb_ld(&(bar)[XB_TMO])) break; if (_sp > XB_SPIN_CAP) { atomicAdd(&(bar)[XB_TMO], 1u); break; } } } } while (0)

struct XcdBarrier {
    unsigned* bar; unsigned x;
    volatile LAS unsigned* st;
};

__device__ __forceinline__ XcdBarrier xcd_barrier_post(unsigned* bar, volatile LAS unsigned* st) {
    XcdBarrier b; b.bar = bar; b.x = xb_xcc_id(); b.st = st;
    if (threadIdx.x == 0) (void)xb_add(&bar[XB_XCNT(b.x)], 1u);
    return b;
}
__device__ __forceinline__ void xcd_barrier_complete(unsigned* bar, unsigned x, unsigned& nloc, unsigned& nx) {
    const unsigned G = gridDim.x * gridDim.y * gridDim.z;
    unsigned sum, cnt, mine, sp = 0u;
    for (;;) {
        sum = 0u; cnt = 0u; mine = 0u;
#pragma unroll
        for (unsigned j = 0; j < 16; ++j) { const unsigned c = xb_ld(&bar[XB_XCNT(j)]); sum += c; cnt += (c > 0u) ? 1u : 0u; mine = (j == x) ? c : mine; }
        if (sum == G) break;
        __builtin_amdgcn_s_sleep(1);
        if ((++sp & 255u) == 0u) { if (xb_ld(&bar[XB_TMO])) break; if (sp > XB_SPIN_CAP) { atomicAdd(&bar[XB_TMO], 1u); break; } }
    }
    nloc = mine > 0u ? mine : 1u; nx = cnt > 0u ? cnt : 1u;
}

__device__ __forceinline__ void xcd_barrier(const XcdBarrier& b) {
    asm volatile("s_waitcnt vmcnt(0)" ::: "memory");
    __syncthreads();
    if (threadIdx.x == 0) {
        unsigned* bar = b.bar;
        __builtin_amdgcn_s_waitcnt(0);
        unsigned nloc = b.st[0], nx = b.st[1];
        if (nloc == 0u) { xcd_barrier_complete(bar, b.x, nloc, nx); b.st[0] = nloc; b.st[1] = nx; }
        const unsigned old = xb_add(&bar[XB_XSUB(b.x)], 1u);
        const unsigned gen = old / nloc;
        if (old + 1u == (gen + 1u) * nloc) {
            __builtin_amdgcn_fence(__ATOMIC_RELEASE, "agent");
            asm volatile("s_waitcnt vmcnt(0)" ::: "memory");
            const unsigned og = xb_add(&bar[XB_TOP], 1u);
            const unsigned tg = og / nx;
            if (og + 1u == (tg + 1u) * nx) xb_add(&bar[XB_TOPGEN], 1u);
            else XB_SPIN(xb_ld(&bar[XB_TOPGEN]) == tg, bar);
            __builtin_amdgcn_fence(__ATOMIC_ACQUIRE, "agent");
            asm volatile("s_waitcnt vmcnt(0)" ::: "memory");
        } else {
            XB_SPIN(xb_ld(&bar[XB_TOPGEN]) == gen, bar);
            __builtin_amdgcn_fence(__ATOMIC_ACQUIRE, "agent");
            asm volatile("s_waitcnt vmcnt(0)" ::: "memory");
        }
    }
    __syncthreads();
}
namespace epi {
using pg8::Unit; using pg8::BM; using pg8::HALF;
typedef float f32x4 __attribute__((ext_vector_type(4)));
__device__ __forceinline__ v2u pk4(const f32x4 v) { v2u w; w.x = pk2(v[0], v[1]); w.y = pk2(v[2], v[3]); return w; }
__device__ __forceinline__ float rstd16(const float* p, float inv_n) { const f32x4* q = (const f32x4*)p; const f32x4 a = (q[0] + q[1]) + (q[2] + q[3]); return 1.0f / sqrtf(((a[0] + a[1]) + (a[2] + a[3])) * inv_n + EPS); }
__device__ __forceinline__ float rstd4(const float* p, float inv_n) { const f32x4 a = *(const GAS f32x4*)p; return 1.0f / sqrtf(((a[0] + a[1]) + (a[2] + a[3])) * inv_n + EPS); }
template <int NP> __device__ __forceinline__ void rstd_rows(const float* ssq, int row0  , int fq, float inv_n, float (&out)[2][4]) {
    f32x4 p[2][4];
#pragma unroll
    for (int ai = 0; ai < 2; ++ai)
#pragma unroll
        for (int m = 0; m < 4; ++m) p[ai][m] = *(const GAS f32x4*)(ssq + (unsigned)(row0 + ai * HALF + m * 16) * NP + (NP == 16 ? 4 * fq : 0));
#pragma unroll
    for (int ai = 0; ai < 2; ++ai)
#pragma unroll
        for (int m = 0; m < 4; ++m) { float t = (p[ai][m][0] + p[ai][m][1]) + (p[ai][m][2] + p[ai][m][3]); if (NP == 16) { t += __shfl_xor(t, 16); t += __shfl_xor(t, 32); } out[ai][m] = __builtin_amdgcn_rsqf(t * inv_n + EPS); }
}
template <int NP> __device__ __forceinline__ void rstd_rows8(const float* ssq, int row0, int fq, float inv_n, float (&out)[8]) {
    f32x4 p[8];
#pragma unroll
    for (int k = 0; k < 8; ++k) p[k] = *(const GAS f32x4*)(ssq + (unsigned)(row0 + k) * NP + (NP == 16 ? 4 * fq : 0));
#pragma unroll
    for (int k = 0; k < 8; ++k) { float t = (p[k][0] + p[k][1]) + (p[k][2] + p[k][3]); if (NP == 16) { t += __shfl_xor(t, 16); t += __shfl_xor(t, 32); } out[k] = __builtin_amdgcn_rsqf(t * inv_n + EPS); }
}
__device__ __forceinline__ int mj_of(int pmg);
template <int NP, int NUR = RS_UNITS, class Sched> __device__ __forceinline__ void rstd_prepass(LAS unsigned char* lds, const float* ssq, const Sched& S, float inv_n, const float* shw = nullptr, int pn_off = 0, int slot0 = 0, bool do_sync = true) {
    int tid_ = threadIdx.x; asm volatile("" : "+v"(tid_)); static_assert(NUR <= RS_UNITS, "slots");
    const int r = NP == 16 ? tid_ >> 1 : tid_ & 255, hf = tid_ & 1; f32x4 p[NUR][NP == 16 ? 2 : 1];
#pragma unroll
    for (int i = 0; i < NUR; ++i) { Unit un; un.pm = 0; un.pn = 0; un.idx = 0; const bool ok = S.next(i, un); const GAS float* q = (const GAS float*)ssq + (unsigned)((ok ? un.pm : 0) * BM + r) * NP + (NP == 16 ? 8 * hf : 0);
        p[i][0] = *(const GAS f32x4*)q; if constexpr (NP == 16) p[i][1] = *(const GAS f32x4*)(q + 4); }
    f32x4 shv = {0.f, 0.f, 0.f, 0.f};
    if (shw) { Unit un; un.pm = 0; un.pn = 0; un.idx = 0; const int i = tid_ >> 6; if (i < RS_UNITS && S.next(i, un)) shv = *(const GAS f32x4*)(shw + (unsigned)mj_of(un.pm) * (2 * D_FF) + (un.pn + pn_off) * BM + 4 * (tid_ & 63)); }
#pragma unroll
    for (int i = 0; i < NUR; ++i) { f32x4 a = p[i][0]; if constexpr (NP == 16) a = a + p[i][1]; float t = (a[0] + a[1]) + (a[2] + a[3]); if constexpr (NP == 16) t += __shfl_xor(t, 1);
        if (NP == 16 ? hf == 0 : tid_ < 256) ((LAS float*)(lds + RS_OFF))[(slot0 + i) * 256 + r] = __builtin_amdgcn_rsqf(t * inv_n + EPS); }
    if (shw && (tid_ >> 6) < RS_UNITS) *(LAS f32x4*)(lds + SH_OFF + tid_ * 16) = shv;
    if (do_sync) __syncthreads();
}
__device__ __forceinline__ void vt_store8(bf16* VT, unsigned boff, int T, int t0, int dv, const float (&v)[8]) {
    *(GAS v4u*)(VT + boff + (unsigned)dv * T + t0) = (v4u){pk2(v[0], v[1]), pk2(v[2], v[3]), pk2(v[4], v[5]), pk2(v[6], v[7])};
}
__device__ __forceinline__ int mj_of(int pmg) { return pmg < 32 ? 0 : 1 + ((pmg - 32) >> 2); }
__device__ __forceinline__ int tseq_of(int pmg, int rl) { return pmg < 32 ? rl : ((pmg - 32) & 3) * 256 + rl; }
__device__ __forceinline__ void rope4(f32x4& x1, f32x4& x2, float pos, const f32x4 inv4) {
#pragma unroll
    for (int j = 0; j < 4; ++j) { float rv = pos * inv4[j] * 0.15915494309189535f; rv -= floorf(rv); const float cs = __builtin_amdgcn_cosf(rv), sn = __builtin_amdgcn_sinf(rv);     const float y1 = x1[j] * cs - x2[j] * sn, y2 = x2[j] * cs + x1[j] * sn; x1[j] = y1; x2[j] = y2; }
}
__device__ __forceinline__ f32x4 inv_freq4(int fq) { f32x4 r;
#pragma unroll
    for (int j = 0; j < 4; ++j) r[j] = exp2f(-(float)(2 * (4 * fq + j)) * (LOG2_ROPE_BASE / 32.f)); return r; }
__device__ __forceinline__ void vt_store(bf16* VT, unsigned boff, int T, int t, int dv0, const f32x4 v) {
#pragma unroll
    for (int j = 0; j < 4; ++j) ((GAS bf16*)VT)[boff + (unsigned)(dv0 + j) * T + t] = (bf16)f2bf(v[j]);
}

template <bool MISC> struct EpiInE {
    static constexpr bool PERM = !MISC, AFTER_DRAIN = false, AROWPERM = false;
    LAS unsigned char* lds; int li, l, pn_off;
    __device__ __forceinline__ void operator()(const f32x4 (&acc)[2][2][4][2], const Unit& u, int wr_, int wc_, int fr_, int fq_) const {
        const float* ssq = WSP(float, WS_SSQ); const float* shw = WSP(float, WS_SHW) + (unsigned)(l * 2) * 9 * 2 * D_FF; bf16* PB = WSP(bf16, WS_PBE); float* ssqc = WSP(float, WS_SSQC); float* LR = WSP(float, WS_LR); bf16* KR = WSP(bf16, WS_KR); float* ockv = o_ckv; float* okrope = o_krope;
        int wr = wr_, wc = wc_, fr = fr_, fq = fq_; asm volatile("" : "+s"(wr), "+s"(wc), "+v"(fr), "+v"(fq));
        int rtok = 0;
        const int pm = u.pm, pn = u.pn + pn_off, mj = mj_of(pm);
        const int cq = PERM ? 8 * fq : 4 * fq, cn = PERM ? 4 : 16;
        const LAS float* shp = (const LAS float*)(lds + SH_OFF) + u.idx * 256 + wc * 32 + cq;
        f32x4 sh[2][2];
#pragma unroll
        for (int bj = 0; bj < 2; ++bj)
#pragma unroll
            for (int n = 0; n < 2; ++n) sh[bj][n] = *(const LAS f32x4*)(shp + bj * HALF + n * cn);
        const f32x4 inv4 = inv_freq4(fq);
        float rs[2][4];
#pragma unroll
        for (int ai = 0; ai < 2; ++ai)
#pragma unroll
            for (int m = 0; m < 4; ++m) rs[ai][m] = ((const LAS float*)(lds + RS_OFF))[ai * HALF + wr * 64 + m * 16 + fr];
#pragma unroll
        for (int ai = 0; ai < 2; ++ai)
#pragma unroll
            for (int m = 0; m < 4; ++m) {
                const int rl = ai * HALF + wr * 64 + m * 16 + fr, row = pm * BM + rl;
                const float rstd = rs[ai][m];
                f32x4 v[2][2];
#pragma unroll
                for (int bj = 0; bj < 2; ++bj)
#pragma unroll
                    for (int n = 0; n < 2; ++n) v[bj][n] = acc[ai][bj][m][n] * rstd + sh[bj][n];
                if (pn <= 7) {
                    const float sc = pn == 0 ? 0.125f : 1.f;
                    bf16* dst = PB + (unsigned)row * PBE_W + pn * BM + wc * 32 + cq;
#pragma unroll
                    for (int bj = 0; bj < 2; ++bj) { const v2u a_ = pk4(v[bj][0] * sc), b_ = pk4(v[bj][1] * sc);
                        if constexpr (PERM) *(GAS v4u*)(dst + bj * HALF) = (v4u){a_.x, a_.y, b_.x, b_.y}; else { *(GAS v2u*)(dst + bj * HALF) = a_; *(GAS v2u*)(dst + bj * HALF + 16) = b_; } }
                    if (pn >= 6) {
                        float s = 0.f;
#pragma unroll
                        for (int bj = 0; bj < 2; ++bj)
#pragma unroll
                            for (int n = 0; n < 2; ++n) { const f32x4 q = v[bj][n] * v[bj][n]; s += (q[0] + q[1]) + (q[2] + q[3]); }
                        s += __shfl_xor(s, 16); s += __shfl_xor(s, 32);
                        if (fq == 0) ((GAS float*)ssqc)[((unsigned)(pn - 6) * M_ALL + row) * 4 + wc] = s;
                        if (pn == 7 && pm < 32) { float* o = ockv + ((unsigned)(pm * N_EVEN + li) * SEQ + rl) * KV_RANK + wc * 32 + cq;
#pragma unroll
                            for (int bj = 0; bj < 2; ++bj)
#pragma unroll
                                for (int n = 0; n < 2; ++n) *(GAS f32x4*)(o + bj * HALF + n * cn) = v[bj][n]; }
                    }
                } else if (wc < 2) {
                    f32x4 x1 = v[0][0], x2 = v[0][1];
                    if (pm < 32) { float* o = okrope + ((unsigned)(pm * N_EVEN + li) * SEQ + rl) * ROPE + wc * 32 + 4 * fq; *(GAS f32x4*)o = x1; *(GAS f32x4*)(o + 16) = x2; }
                    else { const int t = tseq_of(pm, rl); rope4(x1, x2, (float)(wc == 0 ? t >> 6 : t & 63), inv4); }
                    bf16* kd = KR + (unsigned)row * ROPE + wc * 32 + 4 * fq; *(GAS v2u*)kd = pk4(x1); *(GAS v2u*)(kd + 16) = pk4(x2);
                } else if (wc == 2) {
                    float* o = LR + (unsigned)row * 32 + 4 * fq; *(GAS f32x4*)o = v[0][0]; *(GAS f32x4*)(o + 16) = v[0][1];
                }
            }
    }
};

struct EpiInO {
    static constexpr bool PERM = false, AFTER_DRAIN = false, AROWPERM = true;
    LAS unsigned char* lds; int li, l;
    __device__ __forceinline__ void operator()(const f32x4 (&acc)[2][2][4][2], const Unit& u, int wr_, int wc_, int fr_, int fq_) const {
        const float* ssq = WSP(float, WS_SSQ); const float* shw = WSP(float, WS_SHW) + (unsigned)(l * 2) * 9 * 2 * D_FF; bf16* PB = WSP(bf16, WS_PBO); bf16* VD = WSP(bf16, WS_VD); float* odk = o_dk; float* odv = o_dv;
        int wr = wr_, wc = wc_, fr = fr_, fq = fq_; asm volatile("" : "+s"(wr), "+s"(wc), "+v"(fr), "+v"(fq));
        const int pm = u.pm, pn = u.pn, mj = mj_of(pm), rl0 = 128 * wr + 8 * fr;
        const LAS float* shp = (const LAS float*)(lds + SH_OFF) + u.idx * 256 + wc * 32 + 4 * fq;
        f32x4 sh[2][2];
#pragma unroll
        for (int bj = 0; bj < 2; ++bj)
#pragma unroll
            for (int n = 0; n < 2; ++n) sh[bj][n] = *(const LAS f32x4*)(shp + bj * HALF + n * 16);
        const f32x4 inv4 = inv_freq4(fq);
        const int Tb = pm < 32 ? SEQ : DEC_SEQ; const unsigned vbase = (unsigned)(pm < 32 ? pm * SEQ : M_CTX + ((pm - 32) >> 2) * DEC_SEQ) * 1024;
        float rs[8]; { const LAS f32x4* rp = (const LAS f32x4*)(lds + RS_OFF + rl0 * 4); const f32x4 r0 = rp[0], r1 = rp[1];     rs[0] = r0[0]; rs[1] = r0[1]; rs[2] = r0[2]; rs[3] = r0[3]; rs[4] = r1[0]; rs[5] = r1[1]; rs[6] = r1[2]; rs[7] = r1[3]; }
        if (pn < 8) { v2u hold[2][2];
#pragma unroll
            for (int k = 0; k < 8; ++k) {
                const int ai = k >> 2, m = k & 3, rl = rl0 + k, row = pm * BM + rl, t = tseq_of(pm, rl);
                f32x4 v[2][2];
#pragma unroll
                for (int bj = 0; bj < 2; ++bj)
#pragma unroll
                    for (int n = 0; n < 2; ++n) v[bj][n] = acc[ai][bj][m][n] * rs[k] + sh[bj][n];
                if (pn >= 4 && pm < 32) { float* o = odk + ((unsigned)(pm * N_ODD + li) * SEQ + rl) * 1024 + (pn - 4) * BM + wc * 32 + 4 * fq;
#pragma unroll
                    for (int bj = 0; bj < 2; ++bj)
#pragma unroll
                        for (int n = 0; n < 2; ++n) *(GAS f32x4*)(o + bj * HALF + n * 16) = v[bj][n]; }
                if (pm >= 32) { const float pos = (float)((wc & 1) == 0 ? t >> 6 : t & 63); rope4(v[0][0], v[0][1], pos, inv4); rope4(v[1][0], v[1][1], pos, inv4); }
                const float sc = pn < 4 ? DIFF_QSCALE : 1.f;
                if ((k & 1) == 0) {
#pragma unroll
                    for (int bj = 0; bj < 2; ++bj)
#pragma unroll
                        for (int n = 0; n < 2; ++n) hold[bj][n] = pk4(v[bj][n] * sc);
                } else { bf16* dst = PB + (unsigned)(row - 1 + (fq & 1)) * PBO_W + pn * BM + wc * 32 + 4 * (fq & ~1);
#pragma unroll
                    for (int bj = 0; bj < 2; ++bj)
#pragma unroll
                        for (int n = 0; n < 2; ++n) { const v2u cur = pk4(v[bj][n] * sc);
                            const auto rx = __builtin_amdgcn_permlane16_swap(hold[bj][n].x, cur.x, false, false), ry = __builtin_amdgcn_permlane16_swap(hold[bj][n].y, cur.y, false, false);
                            *(GAS v4u*)(dst + bj * HALF + n * 16) = (v4u){rx[0], ry[0], rx[1], ry[1]}; } }
                __builtin_amdgcn_sched_barrier(0);
            }
        } else {
            const int t0 = tseq_of(pm, rl0);
#pragma unroll
            for (int bj = 0; bj < 2; ++bj)
#pragma unroll
                for (int n = 0; n < 2; ++n) {
                    if (pm < 32) {
#pragma unroll
                        for (int k = 0; k < 8; ++k) *(GAS f32x4*)(odv + ((unsigned)(pm * N_ODD + li) * SEQ + rl0 + k) * 1024 + (pn - 8) * BM + bj * HALF + wc * 32 + n * 16 + 4 * fq) = acc[k >> 2][bj][k & 3][n] * rs[k] + sh[bj][n]; }
#pragma unroll
                    for (int j = 0; j < 4; ++j) { float c8[8];
#pragma unroll
                        for (int k = 0; k < 8; ++k) c8[k] = acc[k >> 2][bj][k & 3][n][j] * rs[k] + sh[bj][n][j];
                        vt_store8(VD, vbase + (unsigned)((pn - 8) * 2 + bj) * 128 * Tb, Tb, t0, wc * 32 + n * 16 + 4 * fq + j, c8); }
                    __builtin_amdgcn_sched_barrier(0);
                }
        }
    }
};

struct EpiUq {
    static constexpr bool PERM = false, AFTER_DRAIN = false, AROWPERM = false;
    LAS unsigned char* lds;
    __device__ __forceinline__ void operator()(const f32x4 (&acc)[2][2][4][2], const Unit& u, int wr_, int wc_, int fr_, int fq_) const {
        const float* ssqc = WSP(float, WS_SSQC); bf16* QBUF = WSP(bf16, WS_QBUF);
        int wr = wr_, wc = wc_, fr = fr_, fq = fq_; asm volatile("" : "+s"(wr), "+s"(wc), "+v"(fr), "+v"(fq));
        int rtok = 0;
        const int pm = u.pm, pn = u.pn; const f32x4 inv4 = inv_freq4(fq); v2u hold[2][2];
        float rs[2][4];
#pragma unroll
        for (int ai = 0; ai < 2; ++ai)
#pragma unroll
            for (int m = 0; m < 4; ++m) rs[ai][m] = ((const LAS float*)(lds + RS_OFF))[u.idx * 256 + ai * HALF + wr * 64 + m * 16 + fr];
#pragma unroll
        for (int ai = 0; ai < 2; ++ai)
#pragma unroll
            for (int m = 0; m < 4; ++m) {
                const int rl = ai * HALF + wr * 64 + m * 16 + fr, row = pm * BM + rl;
                const float rstd = rs[ai][m] * MLA_QSCALE;
                f32x4 v[2][2];
#pragma unroll
                for (int bj = 0; bj < 2; ++bj)
#pragma unroll
                    for (int n = 0; n < 2; ++n) v[bj][n] = acc[ai][bj][m][n] * rstd;
                if (pn == 2 && pm >= 32) { const int t = tseq_of(pm, rl); const float pos = (float)((wc & 1) == 0 ? t >> 6 : t & 63); rope4(v[0][0], v[0][1], pos, inv4); rope4(v[1][0], v[1][1], pos, inv4); }
                if ((m & 1) == 0) {
#pragma unroll
                    for (int bj = 0; bj < 2; ++bj)
#pragma unroll
                        for (int n = 0; n < 2; ++n) hold[bj][n] = pk4(v[bj][n]);
                } else { bf16* dst = QBUF + (unsigned)(row - 16 + 16 * (fq & 1)) * QB_W + pn * BM + wc * 32 + 4 * (fq & ~1);
#pragma unroll
                    for (int bj = 0; bj < 2; ++bj)
#pragma unroll
                        for (int n = 0; n < 2; ++n) { const v2u cur = pk4(v[bj][n]);
                            const auto rx = __builtin_amdgcn_permlane16_swap(hold[bj][n].x, cur.x, false, false), ry = __builtin_amdgcn_permlane16_swap(hold[bj][n].y, cur.y, false, false);
                            *(GAS v4u*)(dst + bj * HALF + n * 16) = (v4u){rx[0], ry[0], rx[1], ry[1]}; } }
            }
    }
};

template <int MODE> struct EpiKV {
    static constexpr bool PERM = true, AFTER_DRAIN = false, AROWPERM = true;
    LAS unsigned char* lds; int li;
    __device__ __forceinline__ void operator()(const f32x4 (&acc)[2][2][4][2], const Unit& u, int wr_, int wc_, int fr_, int fq_) const {
        const float* ssqc = WSP(float, WS_SSQC) + (unsigned)M_ALL * 4; bf16* KN = MODE == 1 ? WSP(bf16, WS_KNC) + (unsigned)li * CROWS * 512 : WSP(bf16, WS_KN); bf16* VT = MODE == 1 ? WSP(bf16, WS_VTC) + (unsigned)li * CROWS * 512 : WSP(bf16, WS_VT);
        int wr = wr_, wc = wc_, fr = fr_, fq = fq_; asm volatile("" : "+s"(wr), "+s"(wc), "+v"(fr), "+v"(fq));
        const int pm = u.pm, pn = u.pn, rl0 = 128 * wr + 8 * fr;
        const int Tb = MODE == 1 ? PAST : (pm < 32 ? SEQ : DEC_SEQ);
        const unsigned vbase = (unsigned)(MODE == 1 ? (pm >> 1) * PAST : (pm < 32 ? pm * SEQ : M_CTX + ((pm - 32) >> 2) * DEC_SEQ)) * 512;
        float rs[8];
        if (MODE == 0) { const LAS f32x4* rp = (const LAS f32x4*)(lds + RS_OFF + ((u.idx + 2) * 256 + rl0) * 4);     const f32x4 r0 = rp[0], r1 = rp[1]; rs[0] = r0[0]; rs[1] = r0[1]; rs[2] = r0[2]; rs[3] = r0[3]; rs[4] = r1[0]; rs[5] = r1[1]; rs[6] = r1[2]; rs[7] = r1[3]; }
        else {
#pragma unroll
            for (int k = 0; k < 8; ++k) rs[k] = 1.f; }
        if (pn < 2) {
#pragma unroll
            for (int k = 0; k < 8; ++k) { bf16* dst = KN + (unsigned)(pm * BM + rl0 + k) * 512 + pn * BM + wc * 32 + 8 * fq;
#pragma unroll
                for (int bj = 0; bj < 2; ++bj) { const v2u a_ = pk4(acc[k >> 2][bj][k & 3][0] * rs[k]), b_ = pk4(acc[k >> 2][bj][k & 3][1] * rs[k]); *(GAS v4u*)(dst + bj * HALF) = (v4u){a_.x, a_.y, b_.x, b_.y}; } }
        } else {
            const int t0 = MODE == 1 ? (pm & 1) * 256 + rl0 : tseq_of(pm, rl0);
#pragma unroll
            for (int bj = 0; bj < 2; ++bj)
#pragma unroll
                for (int n = 0; n < 2; ++n)
#pragma unroll
                    for (int j = 0; j < 4; ++j) { float c8[8];
#pragma unroll
                        for (int k = 0; k < 8; ++k) c8[k] = acc[k >> 2][bj][k & 3][n][j] * rs[k];
                        vt_store8(VT, vbase + (unsigned)((pn - 2) * 2 + bj) * 128 * Tb, Tb, t0, wc * 32 + 8 * fq + 4 * n + j, c8); }
        }
    }
};

template <bool IN32> struct EpiOut {
    static constexpr bool PERM = true, AFTER_DRAIN = false, AROWPERM = false;
    LAS unsigned char* lds; int l, down, half;
    __device__ __forceinline__ void operator()(const f32x4 (&acc)[2][2][4][2], const Unit& u, int wr_, int wc_, int fr_, int fq_) const {
        bf16* X = WSP(bf16, WS_X); bf16* XG = WSP(bf16, WS_XG); const float* modl = WSP(float, WS_MODS) + (unsigned)l * 9 * 6 * D; const int ln = l + 1 < DEPTH ? l + 1 : l;
        const float* xp = x_prompt; const float* xs = x_sample;
        float* ssq_out = WSP(float, WS_SSQ) + (down ? 0u : (unsigned)M_ALL * 16); const float* gate = modl + (down ? 5 : 2) * D;
        const int pm_off = down ? half * 32 : 0, write_xg = down ? (l + 1 < DEPTH) : 1;
        int wr = wr_, wc = wc_, fr = fr_, fq = fq_; asm volatile("" : "+s"(wr), "+s"(wc), "+v"(fr), "+v"(fq));
        const int pmg = u.pm + pm_off, pn = u.pn, mj = mj_of(pmg), c0 = pn * BM + wc * 32 + 8 * fq;
        const float* gsp = WSP(float, WS_GS) + (unsigned)((l * 2 + down) * 9 + mj) * D;
        const float* xo = (pmg < 32 ? xp + (unsigned)pmg * BM * D : xs + (unsigned)(pmg - 32) * BM * D) + c0; const bf16* xo16 = X + (unsigned)pmg * BM * D + c0;
        constexpr int DP = IN32 ? 3 : 6;
        f32x4 xb[IN32 ? DP : 1][2][2]; v4u xr[IN32 ? 1 : DP][2];
        int tok = 0;
#define EO_LOAD(buf, q) do { const int rl_ = ((q) >> 2) * HALF + wr * 64 + ((q) & 3) * 16 + fr + tok; \
            _Pragma("unroll") for (int bj = 0; bj < 2; ++bj) { if constexpr (IN32) { xb[buf][bj][0] = *(const GAS f32x4*)(xo + (unsigned)rl_ * D + bj * HALF); xb[buf][bj][1] = *(const GAS f32x4*)(xo + (unsigned)rl_ * D + bj * HALF + 4); } \
                else xr[buf][bj] = *(const GAS v4u*)(xo16 + (unsigned)rl_ * D + bj * HALF); } } while (0)
#define EO_PROC(buf, q) do { const int ai_ = (q) >> 2, m_ = (q) & 3, rl_ = ai_ * HALF + wr * 64 + m_ * 16 + fr; const unsigned row = (unsigned)pmg * BM + rl_; float s = 0.f; \
            _Pragma("unroll") for (int bj = 0; bj < 2; ++bj) { f32x4 r0_, r1_; if constexpr (IN32) { r0_ = xb[buf][bj][0]; r1_ = xb[buf][bj][1]; } \
                else { const v4u w_ = xr[buf][bj]; r0_ = (f32x4){bflo(w_.x), bfhi(w_.x), bflo(w_.y), bfhi(w_.y)}; r1_ = (f32x4){bflo(w_.z), bfhi(w_.z), bflo(w_.w), bfhi(w_.w)}; } \
                const f32x4 x0 = r0_ + gt[bj][0] * acc[ai_][bj][m_][0], x1 = r1_ + gt[bj][1] * acc[ai_][bj][m_][1]; \
                { const v2u a_ = pk4(x0), b_ = pk4(x1); *(GAS v4u*)(X + row * D + c0 + bj * HALF) = (v4u){a_.x, a_.y, b_.x, b_.y}; } \
                const f32x4 q4 = x0 * x0 + x1 * x1; s += (q4[0] + q4[1]) + (q4[2] + q4[3]); \
                if (write_xg) { const v2u a_ = pk4(x0 * gs[bj][0]), b_ = pk4(x1 * gs[bj][1]); *(GAS v4u*)(XG + row * D + c0 + bj * HALF) = (v4u){a_.x, a_.y, b_.x, b_.y}; } } \
            s += __shfl_xor(s, 16); s += __shfl_xor(s, 32); asm volatile("" : "+v"(tok), "+v"(s)); \
            if (fq == 0) ((GAS float*)ssq_out)[row * 16 + pn * 4 + wc] = s; } while (0)
#pragma unroll
        for (int q = 0; q < DP; ++q) EO_LOAD(q % DP, q);
        f32x4 gt[2][2], gs[2][2];
#pragma unroll
        for (int bj = 0; bj < 2; ++bj)
#pragma unroll
            for (int n = 0; n < 2; ++n) { gt[bj][n] = *(const GAS f32x4*)(gate + (unsigned)mj * 6 * D + c0 + bj * HALF + n * 4);
                gs[bj][n] = *(const GAS f32x4*)(gsp + c0 + bj * HALF + n * 4); }
#pragma unroll
        for (int q = 0; q < 8; ++q) { EO_PROC(q % DP, q); if (q + DP < 8) EO_LOAD(q % DP, q + DP); }
#undef EO_LOAD
#undef EO_PROC
    }
};

__device__ __forceinline__ f32x4 dpp_shr1(const f32x4 v) { f32x4 r; const int ln = __lane_id();
#pragma unroll
    for (int j = 0; j < 4; ++j) { const float t = __shfl(v[j], (ln - 1) & 63); r[j] = (ln & 15) == 0 ? 0.f : t; } return r; }
__device__ __forceinline__ f32x4 dpp_shl1(const f32x4 v) { f32x4 r; const int ln = __lane_id();
#pragma unroll
    for (int j = 0; j < 4; ++j) { const float t = __shfl(v[j], (ln + 1) & 63); r[j] = (ln & 15) == 15 ? 0.f : t; } return r; }
#ifndef UC_AT
#define UC_AT 4
#endif
template <bool TAIL> struct EpiUpConv {
    static constexpr bool PERM = TAIL, AFTER_DRAIN = false, AROWPERM = true;
    LAS unsigned char* lds; int l;
    __device__ __forceinline__ void operator()(const f32x4 (&acc)[2][2][4][2], const Unit& u, int wr_, int wc_, int fr_, int fq_) const {
        int wr = wr_, wc = wc_, fr = fr_, fq = fq_; asm volatile("" : "+s"(wr), "+s"(wc), "+v"(fr), "+v"(fq));
        const int pm = u.pm, pn = u.pn, mj = mj_of(pm), t0 = 128 * wr + 8 * fr;
        const float* ssq = WSP(float, WS_SSQ) + (unsigned)M_ALL * 16; const float* shw = WSP(float, WS_SHW) + (unsigned)(l * 2 + 1) * 9 * 2 * D_FF + (unsigned)mj * 2 * D_FF + (TAIL ? UP_FULL_N + pn * HALF : pn * BM);
        const float* cw = ffn_conv_w + (unsigned)l * 3 * 2 * D_FF; const float* cb = ffn_conv_b + (unsigned)l * 2 * D_FF; bf16* ACT = WSP(bf16, WS_ACT); float* UB = WSP(float, WS_UB) + (unsigned)pm * 8 * 2 * D_FF;
        f32x4 C[TAIL ? 1 : 2][10]; int ctok = 0;
#define UC_LOAD(n_) do { const int cl_ = (TAIL ? wc * 32 + 8 * fq : wc * 32 + 16 * (n_) + 4 * fq) + ctok, fa_ = TAIL ? UP_FULL_N / 2 + pn * 64 + 16 * wc + 4 * fq + ctok : pn * HALF + cl_; \
            C[n_][0] = *(const GAS f32x4*)(shw + cl_); C[n_][1] = *(const GAS f32x4*)(shw + (TAIL ? 4 : HALF) + cl_); \
            _Pragma("unroll") for (int d = 0; d < 3; ++d) { C[n_][2 + d] = *(const GAS f32x4*)(cw + d * 2 * D_FF + fa_); C[n_][5 + d] = *(const GAS f32x4*)(cw + d * 2 * D_FF + D_FF + fa_); } \
            C[n_][8] = *(const GAS f32x4*)(cb + fa_); C[n_][9] = *(const GAS f32x4*)(cb + D_FF + fa_); } while (0)
        float rs[8];
        UC_LOAD(0);
        { const LAS f32x4* rp = (const LAS f32x4*)(lds + RS_OFF + t0 * 4); const f32x4 r0 = rp[0], r1 = rp[1];     rs[0] = r0[0]; rs[1] = r0[1]; rs[2] = r0[2]; rs[3] = r0[3]; rs[4] = r1[0]; rs[5] = r1[1]; rs[6] = r1[2]; rs[7] = r1[3]; }
#pragma unroll
        for (int n = 0; n < (TAIL ? 1 : 2); ++n) {
            const int cl = TAIL ? wc * 32 + 8 * fq : wc * 32 + 16 * n + 4 * fq, fa = TAIL ? UP_FULL_N / 2 + pn * 64 + 16 * wc + 4 * fq : pn * HALF + cl;
            const f32x4 sha = C[n][0], shg = C[n][1], ba = C[n][8], bg = C[n][9];
            f32x4 wa[3], wg[3];
#pragma unroll
            for (int d = 0; d < 3; ++d) { wa[d] = C[n][2 + d]; wg[d] = C[n][5 + d]; }
#define UA(k) (acc[(k) >> 2][0][(k) & 3][n] * rs[k] + sha)
#define UG(k) (acc[(k) >> 2][TAIL ? 0 : 1][(k) & 3][TAIL ? 1 : n] * rs[k] + shg)
            v2u hold = {0u, 0u};
            f32x4 a0 = dpp_shr1(UA(7)), g0 = dpp_shr1(UG(7));
            f32x4 a1 = UA(0), g1 = UG(0);
            const f32x4 anx = dpp_shl1(a1), gnx = dpp_shl1(g1);
#pragma unroll
            for (int k = 0; k < 8; ++k) {
                f32x4 a2, g2; if (k < 7) { a2 = UA(k < 7 ? k + 1 : 7); g2 = UG(k < 7 ? k + 1 : 7); } else { a2 = anx; g2 = gnx; }
                const f32x4 ca = ba + wa[0] * a0 + wa[1] * a1 + wa[2] * a2, cg = bg + wg[0] * g0 + wg[1] * g1 + wg[2] * g2;
                const unsigned row = (unsigned)(pm * BM + t0 + k);
                const v2u res = (v2u){pk2(silu_f(ca[0]) * cg[0], silu_f(ca[1]) * cg[1]), pk2(silu_f(ca[2]) * cg[2], silu_f(ca[3]) * cg[3])};
                if ((k & 1) == 0) hold = res;
                else { const auto rx = __builtin_amdgcn_permlane16_swap(hold.x, res.x, false, false), ry = __builtin_amdgcn_permlane16_swap(hold.y, res.y, false, false);
                    const int kk = k - 1 + (fq & 1);
                    if (!((kk == 0 && fr == 0) || (kk == 7 && fr == 15))) *(GAS v4u*)(ACT + (row - 1 + (fq & 1)) * D_FF + fa - 4 * (fq & 1)) = (v4u){rx[0], ry[0], rx[1], ry[1]}; }
                if ((k < 2 && fr == 0) || (k >= 6 && fr == 15)) { float* ub = UB + (unsigned)(wr * 4 + (k < 2 ? k : k - 4)) * 2 * D_FF + fa; *(GAS f32x4*)ub = a1; *(GAS f32x4*)(ub + D_FF) = g1; }
                a0 = a1; g0 = g1; a1 = a2; g1 = g2;
                if constexpr (!TAIL) { if (n == 0 && k == UC_AT) { asm volatile("" : "+v"(ctok), "+v"(a1)); UC_LOAD(1); } }
            }
#undef UA
#undef UG
        }
#undef UC_LOAD
    }
};
}
#ifndef REP_QK
#define REP_QK 1
#endif
namespace attn {
struct KSrc { const bf16* k1; const bf16* k2; const bf16* vt; int ld1, ld2, ldv, pad_; };
template <int DQ> struct Geo { static constexpr int KROW = (DQ + 8) * 2, KTILE = 64 * KROW, VROW = 144, VTILE = 128 * VROW, NKC = DQ / 64; };
__device__ __forceinline__ f32x16 mfma32(bf16x8 a, bf16x8 b, f32x16 c) { return __builtin_amdgcn_mfma_f32_32x32x16_bf16(a, b, c, 0, 0, 0); }

__device__ __forceinline__ KSrc ksel(bool c, const KSrc& a, const KSrc& b) { KSrc r; r.k1 = c ? a.k1 : b.k1; r.k2 = c ? a.k2 : b.k2; r.vt = c ? a.vt : b.vt; r.ld1 = c ? a.ld1 : b.ld1; r.ld2 = c ? a.ld2 : b.ld2; r.ldv = c ? a.ldv : b.ldv; r.pad_ = 0; return r; }
template <int DQ> __device__ __forceinline__ void load_k(const KSrc s, int key0, int tid, v4u (&kr)[Geo<DQ>::NKC]) {
    constexpr int CPR = DQ / 8;
#pragma unroll
    for (int i = 0; i < Geo<DQ>::NKC; ++i) { const int c = tid + NTHR * i, row = c / CPR, ch = c % CPR;
        const bf16* src = (DQ == 192 && ch >= 16) ? s.k2 + (unsigned)((key0 + row) * s.ld2 + (ch - 16) * 8) : s.k1 + (unsigned)((key0 + row) * s.ld1 + ch * 8);
        kr[i] = *(const GAS v4u*)src; }
}
__device__ __forceinline__ void load_v(const KSrc s, int key0, int tid, v4u (&vr)[2]) {
#pragma unroll
    for (int i = 0; i < 2; ++i) { const int c = tid + NTHR * i, dvr = c >> 3, ch = c & 7; vr[i] = *(const GAS v4u*)(s.vt + (unsigned)(dvr * s.ldv + key0 + ch * 8)); }
}
template <int DQ> __device__ __forceinline__ void store_k(LAS unsigned char* kb, int tid, const v4u (&kr)[Geo<DQ>::NKC]) {
    constexpr int CPR = DQ / 8;
#pragma unroll
    for (int i = 0; i < Geo<DQ>::NKC; ++i) { const int c = tid + NTHR * i, row = c / CPR, ch = c % CPR; *(LAS v4u*)(kb + row * Geo<DQ>::KROW + ch * 16) = kr[i]; }
}
template <int DQ> __device__ __forceinline__ void store_v(LAS unsigned char* vb, int tid, const v4u (&vr)[2]) {
#pragma unroll
    for (int i = 0; i < 2; ++i) { const int c = tid + NTHR * i, dvr = c >> 3, ch = c & 7, s = ch >> 1, b = ch & 1; LAS unsigned char* d = vb + dvr * Geo<DQ>::VROW + (16 * s + 4 * b) * 2;
        *(LAS v2u*)d = (v2u){vr[i].x, vr[i].y}; *(LAS v2u*)(d + 16) = (v2u){vr[i].z, vr[i].w}; }
}

#define ATT_DSR(dst, addr, off) asm volatile("ds_read_b128 %0, %1 offset:%2" : "=v"(dst) : "v"(addr), "n"(off))
#define ATT_WAIT(n) do { asm volatile("s_waitcnt lgkmcnt(" #n ")" ::: "memory"); __builtin_amdgcn_sched_barrier(0); } while (0)
template <int DQ, bool COMB = false, bool PP = (DQ == 64)> __device__ __forceinline__ void attn_unit(LAS unsigned char* lds, const bf16* Q, const bf16* Q2, int ldq, const KSrc cs, int nct, const KSrc ns, int nnt, bf16* O, int ldo, float lam = 0.f, float oscale = 1.f, const float* gain = nullptr) {
    typedef Geo<DQ> G;
    int tid_ = threadIdx.x; asm volatile("" : "+v"(tid_));
    const int tid = tid_, lane = tid & 63, w = tid >> 6, n = lane & 31, hh = lane >> 5, grp = __builtin_amdgcn_readfirstlane(tid >> 8);
    constexpr int NS = DQ / 16, NS1 = DQ == 192 ? 8 : 4, STAGE = G::KTILE + G::VTILE;
    static_assert(2 * STAGE <= RING_BYTES, "attention LDS map");
    bf16x8 qf[NS];
    { const bf16* qr = Q + (unsigned)((32 * w + n) * ldq + 8 * hh);
#pragma unroll
      for (int i = 0; i < NS1; ++i) qf[i] = *(const GAS bf16x8*)(qr + 16 * i);
      if (DQ == 192) { const bf16* qr2 = Q2 + (unsigned)((32 * w + n) * ldq + 8 * hh);
#pragma unroll
          for (int i = NS1; i < NS; ++i) qf[i] = *(const GAS bf16x8*)(qr2 + 16 * (i - NS1)); } }
    f32x16 o[4];
#pragma unroll
    for (int d = 0; d < 4; ++d)
#pragma unroll
        for (int r = 0; r < 16; ++r) o[d][r] = 0.f;
    float mrun = -1e30f, lrun = 0.f;
    const int NT = nct + nnt;
    constexpr int AHEAD = DQ == 64 ? 2 : 1;
    v4u krA[G::NKC], vrA[2], krB[AHEAD == 2 ? G::NKC : 1], vrB[AHEAD == 2 ? 2 : 1];
#define ATT_SRC(t) ksel((t) < nct, cs, ns)
#define ATT_KEY0(t) (64 * ((t) < nct ? (t) : (t) - nct))
    load_k<DQ>(ATT_SRC(0), ATT_KEY0(0), tid, krA); load_v(ATT_SRC(0), ATT_KEY0(0), tid, vrA);
    store_k<DQ>(lds, tid, krA); store_v<DQ>(lds + G::KTILE, tid, vrA);
#pragma unroll
    for (int i = 0; i < NS; ++i) asm volatile("" :: "v"(qf[i]));
    if constexpr (AHEAD == 2) { load_k<DQ>(ATT_SRC(1), ATT_KEY0(1), tid, krB); load_v(ATT_SRC(1), ATT_KEY0(1), tid, vrB); }
    __syncthreads();
    const unsigned lds0 = (unsigned)(size_t)lds;
    auto iter = [&](const int tt, auto& kx, auto& vx, auto& ky, auto& vy) __attribute__((always_inline)) {
        const unsigned ka = lds0 + (tt & 1) * STAGE + n * G::KROW + 16 * hh, va = lds0 + (tt & 1) * STAGE + G::KTILE + n * G::VROW + 16 * hh;
        { const int tl = tt + AHEAD < NT ? tt + AHEAD : NT - 1;
          load_k<DQ>(ATT_SRC(tl), ATT_KEY0(tl), tid, kx); load_v(ATT_SRC(tl), ATT_KEY0(tl), tid, vx); }
        asm volatile("s_waitcnt lgkmcnt(0)" ::: "memory");
        f32x16 p0, p1;
        for (int rq_ = 0; rq_ < REP_QK; ++rq_) {
#pragma unroll
        for (int r = 0; r < 16; ++r) { p0[r] = 0.f; p1[r] = 0.f; }
        { v4u kf[3][2];
          ATT_DSR(kf[0][0], ka, 0); ATT_DSR(kf[0][1], ka, 32 * G::KROW);
          ATT_DSR(kf[1][0], ka, 32); ATT_DSR(kf[1][1], ka, 32 * G::KROW + 32);
          __builtin_amdgcn_s_setprio(1);
#pragma unroll
          for (int i = 0; i < NS; ++i) {
              if (i + 2 < NS) { ATT_DSR(kf[(i + 2) % 3][0], ka, 32 * (i + 2)); ATT_DSR(kf[(i + 2) % 3][1], ka, 32 * G::KROW + 32 * (i + 2)); }
              if (i + 2 < NS) ATT_WAIT(4); else if (i + 1 < NS) ATT_WAIT(2); else ATT_WAIT(0);
              p0 = mfma32(__builtin_bit_cast(bf16x8, kf[i % 3][0]), qf[i], p0); p1 = mfma32(__builtin_bit_cast(bf16x8, kf[i % 3][1]), qf[i], p1); }
          __builtin_amdgcn_s_setprio(0); }
        asm volatile("" : "+v"(p0), "+v"(p1)); }
        v4u vf[2][4];
        if constexpr (!PP) {
#pragma unroll
            for (int d = 0; d < 4; ++d) ATT_DSR(vf[0][d], va, d * 32 * G::VROW);
#pragma unroll
            for (int d = 0; d < 4; ++d) ATT_DSR(vf[1][d], va, d * 32 * G::VROW + 32); }
        float mx;
        asm("v_max3_f32 %0, %1, %2, %3" : "=v"(mx) : "v"(p0[0]), "v"(p1[0]), "v"(p0[1]));
#pragma unroll
        for (int r = 1; r < 15; ++r) asm("v_max3_f32 %0, %1, %2, %3" : "=v"(mx) : "v"(mx), "v"(p1[r]), "v"(p0[r + 1]));
        asm("v_max3_f32 %0, %1, %2, %3" : "=v"(mx) : "v"(mx), "v"(p1[15]), "v"(p1[15]));
        const float mxo = __shfl_xor(mx, 32);
        if constexpr (PP) {
            if (grp == 1 && tt + 1 < NT) { store_k<DQ>(lds + ((tt + 1) & 1) * STAGE, tid, ky); store_v<DQ>(lds + ((tt + 1) & 1) * STAGE + G::KTILE, tid, vy); }
            __syncthreads();
#pragma unroll
            for (int d = 0; d < 4; ++d) ATT_DSR(vf[0][d], va, d * 32 * G::VROW);
#pragma unroll
            for (int d = 0; d < 4; ++d) ATT_DSR(vf[1][d], va, d * 32 * G::VROW + 32); }
        asm("v_max_f32 %0, %1, %2" : "=v"(mx) : "v"(mx), "v"(mxo));
        if (__builtin_amdgcn_ballot_w64(mx > mrun + 8.f) != 0) { const float mnew = fmaxf(mrun, mx), alpha = ex2(mrun - mnew); mrun = mnew; lrun *= alpha;
#pragma unroll
            for (int d = 0; d < 4; ++d)
#pragma unroll
                for (int r = 0; r < 16; ++r) o[d][r] *= alpha; }
        const f32x2_t mref2 = {mrun, mrun}; f32x2_t ls2 = {0.f, 0.f};
        auto exps = [&](const int s, const int part) __attribute__((always_inline)) { const int r = 8 * (s & 1) + 2 * part;
            if (s >> 1) { f32x2_t t = (f32x2_t){p1[r], p1[r + 1]} - mref2; t[0] = ex2(t[0]); t[1] = ex2(t[1]); ls2 += t; p1[r] = t[0]; p1[r + 1] = t[1]; }
            else { f32x2_t t = (f32x2_t){p0[r], p0[r + 1]} - mref2; t[0] = ex2(t[0]); t[1] = ex2(t[1]); ls2 += t; p0[r] = t[0]; p0[r + 1] = t[1]; } };
#pragma unroll
        for (int part = 0; part < 4; ++part) exps(0, part);
#pragma unroll
        for (int s = 0; s < 4; ++s) { v4u pw;
#pragma unroll
            for (int j = 0; j < 4; ++j) { const int r = 8 * (s & 1) + 2 * j; pw[j] = (s >> 1) ? pk2(p1[r], p1[r + 1]) : pk2(p0[r], p0[r + 1]); }
            const bf16x8 pf = __builtin_bit_cast(bf16x8, pw);
            if (s == 0) ATT_WAIT(4); else if (s == 1) ATT_WAIT(4); else if (s == 2) ATT_WAIT(4); else ATT_WAIT(0);
            if (s == 3) __builtin_amdgcn_s_setprio(1);
#pragma unroll
            for (int d = 0; d < 4; ++d) { o[d] = mfma32(__builtin_bit_cast(bf16x8, vf[s & 1][d]), pf, o[d]); if (s < 3) exps(s + 1, d); __builtin_amdgcn_sched_barrier(0); }
            if (s == 3) __builtin_amdgcn_s_setprio(0);
            if (s + 2 < 4) {
#pragma unroll
                for (int d = 0; d < 4; ++d) ATT_DSR(vf[s & 1][d], va, d * 32 * G::VROW + 32 * (s + 2)); } }
        lrun += ls2[0] + ls2[1];
        __builtin_amdgcn_sched_barrier(0);
        if ((!PP || grp == 0) && tt + 1 < NT) { store_k<DQ>(lds + ((tt + 1) & 1) * STAGE, tid, ky); store_v<DQ>(lds + ((tt + 1) & 1) * STAGE + G::KTILE, tid, vy); }
        __syncthreads();
    };
    if constexpr (PP) { if (grp == 1) __builtin_amdgcn_s_barrier(); }
    if constexpr (AHEAD == 2) { for (int tt = 0; tt < NT; tt += 2) { iter(tt, krA, vrA, krB, vrB); iter(tt + 1, krB, vrB, krA, vrA); } }
    else { for (int tt = 0; tt < NT; ++tt) iter(tt, krA, vrA, krA, vrA); }
    if constexpr (PP) { if (grp == 0) __builtin_amdgcn_s_barrier(); }
#undef ATT_SRC
#undef ATT_KEY0
    const float inv = 1.0f / (lrun + __shfl_xor(lrun, 32));
    bf16* orow = O + (unsigned)((32 * w + n) * ldo + 4 * hh);
    if constexpr (COMB) {
        asm volatile("s_waitcnt vmcnt(0)" ::: "memory");
        float ss = 0.f;
#pragma unroll
        for (int d = 0; d < 4; ++d)
#pragma unroll
            for (int r4 = 0; r4 < 4; ++r4) { const v2u w0 = *(const GAS v2u*)(orow + 32 * d + 8 * r4);
                o[d][4 * r4] = bflo(w0.x) - lam * (o[d][4 * r4] * inv); o[d][4 * r4 + 1] = bfhi(w0.x) - lam * (o[d][4 * r4 + 1] * inv); o[d][4 * r4 + 2] = bflo(w0.y) - lam * (o[d][4 * r4 + 2] * inv); o[d][4 * r4 + 3] = bfhi(w0.y) - lam * (o[d][4 * r4 + 3] * inv);
                ss += (o[d][4 * r4] * o[d][4 * r4] + o[d][4 * r4 + 1] * o[d][4 * r4 + 1]) + (o[d][4 * r4 + 2] * o[d][4 * r4 + 2] + o[d][4 * r4 + 3] * o[d][4 * r4 + 3]); }
        ss += __shfl_xor(ss, 32);
        const float rs = oscale / sqrtf(ss * (1.f / 128.f) + EPS);
#pragma unroll
        for (int d = 0; d < 4; ++d)
#pragma unroll
            for (int r4 = 0; r4 < 4; r4 += 2) { const f32x4 g4 = *(const GAS f32x4*)(gain + 32 * d + 8 * r4 + 4 * hh), h4 = *(const GAS f32x4*)(gain + 32 * d + 8 * r4 + 8 + 4 * hh);
                v2u wa, wb; wa.x = pk2(o[d][4 * r4] * rs * g4[0], o[d][4 * r4 + 1] * rs * g4[1]); wa.y = pk2(o[d][4 * r4 + 2] * rs * g4[2], o[d][4 * r4 + 3] * rs * g4[3]);
                wb.x = pk2(o[d][4 * r4 + 4] * rs * h4[0], o[d][4 * r4 + 5] * rs * h4[1]); wb.y = pk2(o[d][4 * r4 + 6] * rs * h4[2], o[d][4 * r4 + 7] * rs * h4[3]);
                const auto rx = __builtin_amdgcn_permlane32_swap(wa.x, wb.x, false, false), ry = __builtin_amdgcn_permlane32_swap(wa.y, wb.y, false, false);
                *(GAS v4u*)(O + (unsigned)((32 * w + n) * ldo + 8 * hh) + 32 * d + 8 * r4) = (v4u){rx[0], ry[0], rx[1], ry[1]}; }
    } else {
    bf16* orow16 = O + (unsigned)((32 * w + n) * ldo + 8 * hh);
#pragma unroll
    for (int d = 0; d < 4; ++d)
#pragma unroll
        for (int r4 = 0; r4 < 4; r4 += 2) { v2u wa, wb; wa.x = pk2(o[d][4 * r4] * inv, o[d][4 * r4 + 1] * inv); wa.y = pk2(o[d][4 * r4 + 2] * inv, o[d][4 * r4 + 3] * inv);
            wb.x = pk2(o[d][4 * r4 + 4] * inv, o[d][4 * r4 + 5] * inv); wb.y = pk2(o[d][4 * r4 + 6] * inv, o[d][4 * r4 + 7] * inv);
            const auto rx = __builtin_amdgcn_permlane32_swap(wa.x, wb.x, false, false), ry = __builtin_amdgcn_permlane32_swap(wa.y, wb.y, false, false);
            *(GAS v4u*)(orow16 + 32 * d + 8 * r4) = (v4u){rx[0], ry[0], rx[1], ry[1]}; }
    }
}
#undef ATT_DSR
#undef ATT_WAIT
}
namespace gla {
using attn::mfma32;
constexpr int RS_ = 144;
constexpr int L_QD = 0, L_KD = L_QD + 64 * RS_, L_KST = L_KD + 64 * RS_, L_VTT = L_KST + 64 * RS_, L_EBL = L_VTT + 128 * RS_, L_GT = L_EBL + 256, L_END = L_GT + 8 * 64 * 4;
__device__ __forceinline__ bf16x8 rd2(const LAS unsigned char* p, int off2) { if (off2 == 8) return *(const LAS bf16x8*)p; const v2u lo = *(const LAS v2u*)p, hi = *(const LAS v2u*)(p + off2); const v4u v = {lo.x, lo.y, hi.x, hi.y}; return __builtin_bit_cast(bf16x8, v); }
__device__ __forceinline__ bf16x8 packacc(const f32x16& a, int half) { v4u pw;
#pragma unroll
    for (int j = 0; j < 4; ++j) pw[j] = pk2(a[8 * half + 2 * j], a[8 * half + 2 * j + 1]);
    return __builtin_bit_cast(bf16x8, pw); }

__device__ __forceinline__ void ld_unit(const float* LR, float* LD, int row0, int T, int h, int dir, const float* wd  , const float* bd  ) {
    int tid_ = threadIdx.x; asm volatile("" : "+v"(tid_));
    const int lane = tid_ & 63, w = __builtin_amdgcn_readfirstlane(tid_ >> 6), n = lane & 31, hh = lane >> 5;
    float bv[2][8], bdv[2];
#pragma unroll
    for (int cb = 0; cb < 2; ++cb) { bdv[cb] = ((const GAS float*)bd)[h * DK_A + 32 * cb + n];
#pragma unroll
        for (int i = 0; i < 8; ++i) bv[cb][i] = ((const GAS float*)wd)[(2 * i + hh) * 256 + h * DK_A + 32 * cb + n]; }
    for (int rb = w; rb < T / 32; rb += NWAVES) { float av[8]; const GAS float* lrrow = (const GAS float*)LR + (size_t)(row0 + 32 * rb + n) * 32 + dir * 16 + hh;
#pragma unroll
        for (int i = 0; i < 8; ++i) av[i] = lrrow[2 * i];
#pragma unroll
        for (int cb = 0; cb < 2; ++cb) { f32x16 acc;
#pragma unroll
            for (int r = 0; r < 16; ++r) acc[r] = 0.f;
#pragma unroll
            for (int i = 0; i < 8; ++i) acc = __builtin_amdgcn_mfma_f32_32x32x2f32(av[i], bv[cb][i], acc, 0, 0, 0);
            GAS float* ldp = (GAS float*)LD + (size_t)(row0 + 32 * rb + 4 * hh) * 512 + dir * 256 + h * DK_A + 32 * cb + n;
#pragma unroll
            for (int r = 0; r < 16; ++r) ldp[(size_t)((r & 3) + 8 * (r >> 2)) * 512] = logsigmoid_f(acc[r] + bdv[cb]) * (1.f / 16.f); } }
    VM_WAIT(); __syncthreads();
}

__device__ __forceinline__ void gla_unit(LAS unsigned char* lds, const bf16* PB, const float* LD, int row0, int T, int h, int dir,
                                         const float* s0  , float* sout  , bf16* OUT, int ldo) {
    int tid_ = threadIdx.x; asm volatile("" : "+v"(tid_));
    const int tid = tid_, lane = tid & 63, w = tid >> 6, n = lane & 31, hh = lane >> 5, dvt = w & 3, tt = w >> 2;
    const int kc = tid & 63, g = tid >> 6;
    const int dvc = tid & 127, gv = tid >> 7;
    f32x16 sacc[2];
#pragma unroll
    for (int kt = 0; kt < 2; ++kt)
#pragma unroll
        for (int r = 0; r < 16; ++r) { const int k = 32 * kt + (r & 3) + 8 * (r >> 2) + 4 * hh; sacc[kt][r] = s0 ? ((const GAS float*)s0)[k * DV_A + 32 * dvt + n] : 0.f; }
    const int NC = T / 64;
    unsigned qraw[8], kraw[8], vraw[16]; float ldr[8];
    const int sgn = dir ? -1 : 1;
    const unsigned qk0 = (unsigned)(((dir ? 63 - 8 * g : 8 * g) * PBE_W + h * DK_A + kc) * 2), v0 = (unsigned)(((dir ? 63 - 16 * gv : 16 * gv) * PBE_W + 512 + h * DV_A + dvc) * 2);
    const unsigned ld0 = (unsigned)(((dir ? 63 - 8 * g : 8 * g) * 512 + dir * 256 + h * DK_A + kc) * 4);
    const int pstep = sgn * PBE_W * 2;
#define GLA_LOAD(c_) do { const int tlo_ = dir ? T - 64 * ((c_) + 1) : 64 * (c_); \
        const GAS unsigned char* pb_ = (const GAS unsigned char*)PB + (size_t)(row0 + tlo_) * PBE_W * 2; const GAS unsigned char* lb_ = (const GAS unsigned char*)LD + (size_t)(row0 + tlo_) * 512 * 4; \
        _Pragma("unroll") for (int j = 0; j < 8; ++j) ldr[j] = *(const GAS float*)(lb_ + (ld0 + (unsigned)(j * sgn * 512 * 4))); \
        _Pragma("unroll") for (int j = 0; j < 8; ++j) { const unsigned o_ = qk0 + (unsigned)(j * pstep); qraw[j] = *(const GAS unsigned short*)(pb_ + o_); kraw[j] = *(const GAS unsigned short*)(pb_ + o_ + 512); } \
        _Pragma("unroll") for (int j = 0; j < 16; ++j) { vraw[j] = *(const GAS unsigned short*)(pb_ + (v0 + (unsigned)(j * pstep))); } } while (0)
    GLA_LOAD(0);
    for (int c = 0; c < NC; ++c) {
        float qv[8], kv[8];
#pragma unroll
        for (int j = 0; j < 8; ++j) { qv[j] = bf2f((unsigned short)qraw[j]); kv[j] = bf2f((unsigned short)kraw[j]); }
        float bc[8]; float run = 0.f;
#pragma unroll
        for (int j = 0; j < 8; ++j) { run += ldr[j]; bc[j] = run; }
        *(LAS float*)(lds + L_GT + (g * 64 + kc) * 4) = run;
        __syncthreads();
        { unsigned w4[8];
#pragma unroll
          for (int j = 0; j < 8; ++j) w4[j] = (vraw[2 * j] & 0xffffu) | (vraw[2 * j + 1] << 16);
          LAS unsigned char* d = lds + L_VTT + dvc * RS_ + 32 * gv;
          *(LAS v4u*)d = (v4u){w4[0], w4[1], w4[2], w4[3]}; *(LAS v4u*)(d + 16) = (v4u){w4[4], w4[5], w4[6], w4[7]}; }
        float pre = 0.f, bl = 0.f;
#pragma unroll
        for (int g2 = 0; g2 < 8; ++g2) { const float t = *(LAS float*)(lds + L_GT + (g2 * 64 + kc) * 4); bl += t; if (g2 < g) pre += t; }
        const float ebl = __expf(bl);
        { unsigned ks[4];
#pragma unroll
          for (int j = 0; j < 8; ++j) { const float b = pre + bc[j]; const float e = __expf(b), ei = __builtin_amdgcn_rcpf(e); const int p = 8 * g + j;
              *(LAS bf16*)(lds + L_QD + p * RS_ + kc * 2) = (bf16)f2bf(qv[j] * e); *(LAS bf16*)(lds + L_KD + p * RS_ + kc * 2) = (bf16)f2bf(kv[j] * ei);
              const float kd = kv[j] * (ebl * ei); if (j & 1) ks[j >> 1] |= f2bf(kd) << 16; else ks[j >> 1] = f2bf(kd); }
          *(LAS v4u*)(lds + L_KST + kc * RS_ + 16 * g) = (v4u){ks[0], ks[1], ks[2], ks[3]}; }
        if (g == 0) *(LAS float*)(lds + L_EBL + kc * 4) = ebl;
        __syncthreads();
        if (c + 1 < NC) GLA_LOAD(c + 1);
        f32x16 o;
#pragma unroll
        for (int r = 0; r < 16; ++r) o[r] = 0.f;
#pragma unroll
        for (int kt = 0; kt < 2; ++kt)
#pragma unroll
            for (int hf = 0; hf < 2; ++hf) { const bf16x8 a = rd2(lds + L_QD + (32 * tt + n) * RS_ + (32 * kt + 16 * hf + 4 * hh) * 2, 16); o = mfma32(a, packacc(sacc[kt], hf), o); }
#pragma unroll
        for (int st = 0; st < 2; ++st) if (st <= tt) {
            f32x16 at;
#pragma unroll
            for (int r = 0; r < 16; ++r) at[r] = 0.f;
#pragma unroll
            for (int i = 0; i < 4; ++i) { const bf16x8 a = rd2(lds + L_KD + (32 * st + n) * RS_ + (16 * i + 8 * hh) * 2, 8), b = rd2(lds + L_QD + (32 * tt + n) * RS_ + (16 * i + 8 * hh) * 2, 8); at = mfma32(a, b, at); }
            if (st == tt) {
#pragma unroll
                for (int r = 0; r < 16; ++r) { const int s = (r & 3) + 8 * (r >> 2) + 4 * hh; if (s > n) at[r] = 0.f; } }
#pragma unroll
            for (int hf = 0; hf < 2; ++hf) { const bf16x8 b = rd2(lds + L_VTT + (32 * dvt + n) * RS_ + (32 * st + 16 * hf + 4 * hh) * 2, 16); o = mfma32(packacc(at, hf), b, o); }
        }
#pragma unroll
        for (int kt = 0; kt < 2; ++kt) {
#pragma unroll
            for (int r4 = 0; r4 < 4; ++r4) { const f32x4 e4 = *(const LAS f32x4*)(lds + L_EBL + (32 * kt + 8 * r4 + 4 * hh) * 4);
#pragma unroll
                for (int j = 0; j < 4; ++j) sacc[kt][4 * r4 + j] *= e4[j]; }
#pragma unroll
            for (int i = 0; i < 4; ++i) { const bf16x8 a = rd2(lds + L_KST + (32 * kt + n) * RS_ + (16 * i + 8 * hh) * 2, 8), b = rd2(lds + L_VTT + (32 * dvt + n) * RS_ + (16 * i + 8 * hh) * 2, 8); sacc[kt] = mfma32(a, b, sacc[kt]); }
        }
        { const int tlo = dir ? T - 64 * (c + 1) : 64 * c; GAS unsigned char* ob = (GAS unsigned char*)OUT + (size_t)(row0 + tlo) * ldo * 2;
          const unsigned o0 = (unsigned)(((dir ? 63 - 32 * tt - 4 * hh : 32 * tt + 4 * hh) * ldo + 32 * dvt + n) * 2); const int ostep = sgn * ldo * 2;
#pragma unroll
          for (int r = 0; r < 16; ++r) *(GAS bf16*)(ob + (o0 + (unsigned)(((r & 3) + 8 * (r >> 2)) * ostep))) = (bf16)f2bf(o[r]); }
    }
    if (sout && tt == 0) {
#pragma unroll
        for (int kt = 0; kt < 2; ++kt)
#pragma unroll
            for (int r = 0; r < 16; ++r) { const int k = 32 * kt + (r & 3) + 8 * (r >> 2) + 4 * hh; ((GAS float*)sout)[k * DV_A + 32 * dvt + n] = sacc[kt][r]; }
    }
    __syncthreads();
#undef GLA_LOAD
}
}
#ifndef REP_LD
#define REP_LD 1
#endif
#ifndef REP_E3
#define REP_E3 1
#endif
#ifndef REP_P0A
#define REP_P0A 1
#endif
#ifndef REP_MLA
#define REP_MLA 1
#endif
#ifndef REP_MODS
#define REP_MODS 1
#endif
#ifndef REP_TR
#define REP_TR 1
#endif
#ifndef REP_CACHE
#define REP_CACHE 1
#endif
#ifndef REP_P0B
#define REP_P0B 1
#endif
#ifndef REP_GLA
#define REP_GLA 1
#endif
#ifndef REP_BAR
#define REP_BAR 0
#endif
#ifndef REP_IN
#define REP_IN 1
#endif
#ifndef REP_E2
#define REP_E2 1
#endif
#ifndef REP_UP
#define REP_UP 1
#endif
#ifndef REP_O3
#define REP_O3 1
#endif
struct Args { const float* in[30]; float* out; unsigned char* ws; };
static_assert(sizeof(Args) == 32 * 8, "Args has padding");

__device__ __forceinline__ void p0_transpose_blk(const float* W, int K, int N, bf16* WT, LAS float* scr, int k0, int n0, int dn0, const float* kgain, int lane, int imode = 0) {
    LAS bf16* t = (LAS bf16*)scr; constexpr int TS = 136;
    f32x4 v[16];
#pragma unroll
    for (int i = 0; i < 16; ++i) { const int kk = 8 * i + (lane >> 3); v[i] = *(const GAS f32x4*)(W + (size_t)(k0 + kk) * N + n0 + (lane & 7) * 4); }
    if (kgain) {
#pragma unroll
        for (int i = 0; i < 16; ++i) v[i] = v[i] * ((const GAS float*)kgain)[k0 + 8 * i + (lane >> 3)]; }
#pragma unroll
    for (int i = 0; i < 16; ++i) { const int kk = 8 * i + (lane >> 3); LAS bf16* d = t + ((lane & 7) * 4) * TS + kk; const unsigned lo = pk2(v[i][0], v[i][1]), hi = pk2(v[i][2], v[i][3]);
        d[0] = (bf16)lo; d[TS] = (bf16)(lo >> 16); d[2 * TS] = (bf16)hi; d[3 * TS] = (bf16)(hi >> 16); }
    LDS_WAIT(); asm volatile("" ::: "memory");
#pragma unroll
    for (int j = 0; j < 8; ++j) { const int n = 4 * j + (lane >> 4), c = lane & 15, dr = imode ? 32 * (n >> 4) + 8 * ((n >> 2) & 3) + (n & 3) + (imode == 2 ? 4 : 0) : n; *(GAS v4u*)(WT + (size_t)(dn0 + dr) * K + k0 + 8 * c) = *(const LAS v4u*)(t + n * TS + 8 * c); }
    LDS_WAIT(); asm volatile("" ::: "memory");
}
__device__ __forceinline__ float dpp_row_shr(float v, int n) {
    const int iv = __builtin_bit_cast(int, v); int r;
    switch (n) { case 1: r = __builtin_amdgcn_update_dpp(0, iv, 0x111, 0xf, 0xf, true); break; case 2: r = __builtin_amdgcn_update_dpp(0, iv, 0x112, 0xf, 0xf, true); break;
                 case 4: r = __builtin_amdgcn_update_dpp(0, iv, 0x114, 0xf, 0xf, true); break; default: r = __builtin_amdgcn_update_dpp(0, iv, 0x118, 0xf, 0xf, true); break; }
    return __builtin_bit_cast(float, r);
}
__device__ __forceinline__ float wave_sum_l63(float v) {
    v += dpp_row_shr(v, 1); v += dpp_row_shr(v, 2); v += dpp_row_shr(v, 4); v += dpp_row_shr(v, 8);
    v += __builtin_bit_cast(float, __builtin_amdgcn_update_dpp(0, __builtin_bit_cast(int, v), 0x142, 0xa, 0xf, false));
    v += __builtin_bit_cast(float, __builtin_amdgcn_update_dpp(0, __builtin_bit_cast(int, v), 0x143, 0xc, 0xf, false));
    return v;
}
__device__ __forceinline__ int opaque_tid() { int t = threadIdx.x; asm volatile("" : "+v"(t)); return t; }
__device__ __forceinline__ float wave_sum(float v) {
#pragma unroll
    for (int o = 1; o < 64; o <<= 1) v += __shfl_xor(v, o);
    return v;
}

__device__ __forceinline__ void p0_cache_copy(const float* src, bf16* dst, int nb, int nl, int inner, i64 t0, i64 nthr) {
    const i64 in4 = inner / 4, n4 = (i64)nb * nl * in4;
    for (i64 i0 = t0; i0 < n4; i0 += 4 * nthr) { f32x4 v[4];
#pragma unroll
        for (int u = 0; u < 4; ++u) { const i64 i = i0 + u * nthr; if (i < n4) v[u] = ((const GAS f32x4*)src)[i]; }
#pragma unroll
        for (int u = 0; u < 4; ++u) { const i64 i = i0 + u * nthr; if (i < n4) { const i64 e4 = i % in4, bl2 = i / in4, b = bl2 / nl, lq = bl2 % nl; *(GAS v2u*)(dst + ((lq * nb + b) * inner + e4 * 4)) = epi::pk4(v[u]); } } }
}

__device__ __forceinline__ void gla_combine(bf16* MIX, const bf16* OGB, const bf16* PBE, const float* gain, int r0, int nr, int h0, int nh, int wave, int lane) {
    for (int it0 = wave; it0 < nr * nh; it0 += 4 * NWAVES) { GAS unsigned* mp[4]; unsigned a[4], b[4], gq[4];
#pragma unroll
        for (int u = 0; u < 4; ++u) { const int it = it0 + u * NWAVES, row = r0 + it / nh, h = h0 + it % nh;
            mp[u] = (GAS unsigned*)(MIX + (size_t)row * MIXW + h * DV_A) + lane; a[u] = *mp[u]; b[u] = ((const GAS unsigned*)(OGB + (size_t)row * 512 + h * DV_A))[lane]; gq[u] = ((const GAS unsigned*)(PBE + (size_t)row * PBE_W + 1024 + h * DV_A))[lane]; }
        const GAS float* gg = (const GAS float*)gain + 2 * lane; const float g0 = gg[0], g1 = gg[1];
#pragma unroll
        for (int u = 0; u < 4; ++u) { const float o0 = bflo(a[u]) + bflo(b[u]), o1 = bfhi(a[u]) + bfhi(b[u]);
            const float rstd = __builtin_amdgcn_rsqf(__builtin_bit_cast(float, __builtin_amdgcn_readlane(__builtin_bit_cast(int, wave_sum_l63(o0 * o0 + o1 * o1)), 63)) * (1.f / DV_A) + EPS);
            *mp[u] = pk2(o0 * rstd * g0 * silu_f(bflo(gq[u])), o1 * rstd * g1 * silu_f(bfhi(gq[u]))); } }
}

__global__ void __launch_bounds__(NTHR, 2) mk_fwd(Args args) {
    extern __shared__ __attribute__((aligned(16))) unsigned char lds_raw[];
    LAS unsigned char* const lds0 = (LAS unsigned char*)lds_raw; LAS unsigned char* lds = lds0;
    #define MISC ((volatile LAS unsigned*)(lds + MISC_OFF))
    for (int u = threadIdx.x; u < (LDS_BYTES - LDSCTL_OFF) / 4; u += NTHR) ((LAS unsigned*)(lds + LDSCTL_OFF))[u] = 0u;
    __syncthreads();
    if (threadIdx.x == 0) {
#pragma unroll
        for (int k = 0; k < 30; ++k) ((LAS unsigned long long*)(lds + ARGS_OFF))[k] = (unsigned long long)args.in[k];
        ((LAS unsigned long long*)(lds + ARGS_OFF))[30] = (unsigned long long)args.out; ((LAS unsigned long long*)(lds + ARGS_OFF))[31] = (unsigned long long)args.ws;
    }
    __syncthreads();
    { XcdBarrier b0 = xcd_barrier_post((unsigned*)((gu32*)(args.ws + WS_CTL) + CW_BAR), MISC + 8); if (threadIdx.x == 0) MISC[10] = b0.x; }
    __syncthreads();
#define GRID_BAR() do { XcdBarrier b_; b_.bar = (unsigned*)((gu32*)(WSB + WS_CTL) + CW_BAR); b_.x = (unsigned)__builtin_amdgcn_readfirstlane((int)MISC[10]); b_.st = MISC + 8; xcd_barrier(b_); { unsigned o_ = 0; asm volatile("" : "+s"(o_)); lds = lds0 + o_; } } while (0)
#define TID (opaque_tid())
#define LANE (TID & 63)
#define WAVE (__builtin_amdgcn_readfirstlane(TID >> 6))
#define GSIZE ((int)gridDim.x)
#define VCU ((int)((blockIdx.x & 7) * (gridDim.x >> 3) + (blockIdx.x >> 3)))
#define GTHREADS(i, n) for (i64 i = (i64)blockIdx.x * NTHR + TID, _n = (n); i < _n; i += (i64)GSIZE * NTHR)
#define GWAVES(i, n) for (i64 i = (i64)blockIdx.x * NWAVES + WAVE, _n = (n); i < _n; i += (i64)GSIZE * NWAVES)
#define GEMM(EPI, Aptr, LDA, Bptr, LDB, Mv, Nv, Kv) GEMM_SUB(EPI, Aptr, LDA, Bptr, LDB, Mv, Nv, Kv, 0, GSIZE)
#define GEMM_SUB(EPI, Aptr, LDA, Bptr, LDB, Mv, Nv, Kv, W0, WN) do { int k_ = (Kv); asm volatile("" : "+s"(k_));     \
        const pg8::Gemm g_{(const pg8::bf16_t*)(Aptr), (const pg8::bf16_t*)(Bptr), (Mv), (Nv), k_, (LDA), (LDB)}; int G_ = (WN), c_ = (int)blockIdx.x - (W0); if (c_ >= G_) c_ = -1; asm volatile("" : "+s"(G_), "+s"(c_));     \
        pg8::StaticOrder S_; S_.init((Mv), (Nv), G_, c_); \
        pg8::gemm_phase<decltype(EPI), pg8::StaticOrder, true, true>(lds, g_, S_, (EPI)); } while (0)
#define GEMM_SUB_RS4(EPI, SSQP, INVN, Aptr, LDA, Bptr, LDB, Mv, Nv, Kv, W0, WN) do { int k_ = (Kv); asm volatile("" : "+s"(k_));     \
        const pg8::Gemm g_{(const pg8::bf16_t*)(Aptr), (const pg8::bf16_t*)(Bptr), (Mv), (Nv), k_, (LDA), (LDB)}; int G_ = (WN), c_ = (int)blockIdx.x - (W0); if (c_ >= G_) c_ = -1; asm volatile("" : "+s"(G_), "+s"(c_));     \
        pg8::StaticOrder S_; S_.init((Mv), (Nv), G_, c_); epi::rstd_prepass<4>(lds, (SSQP), S_, (INVN)); \
        pg8::gemm_phase<decltype(EPI), pg8::StaticOrder, true, true>(lds, g_, S_, (EPI)); } while (0)
#define GEMM_RS(EPI, SSQP, SHWP, Aptr, LDA, Bptr, LDB, Mv, Nv, Kv) do { int k_ = (Kv); asm volatile("" : "+s"(k_));     \
        const pg8::Gemm g_{(const pg8::bf16_t*)(Aptr), (const pg8::bf16_t*)(Bptr), (Mv), (Nv), k_, (LDA), (LDB)}; int G_ = GSIZE, c_ = (int)blockIdx.x; asm volatile("" : "+s"(G_), "+s"(c_));     \
        pg8::StaticOrder S_; S_.init((Mv), (Nv), G_, c_); epi::rstd_prepass<16, 1>(lds, (SSQP), S_, 1.f / D, (SHWP));     \
        pg8::gemm_phase<decltype(EPI), pg8::StaticOrder, true, true>(lds, g_, S_, (EPI)); } while (0)

    for (int rep_ = 0; rep_ < REP_P0A; ++rep_) {
        LAS float* sv = (LAS float*)lds;
        for (int e = TID; e < 9 * D; e += NTHR) { const int j = e / D, k = e % D; sv[e] = silu_f(j == 0 ? c_ctx[k] : cvec[(size_t)(j - 1) * D + k]); }
        __syncthreads();
        for (int rm_ = 0; rm_ < REP_MODS; ++rm_) { LAS float* part = (LAS float*)(lds + 40960);
          for (int task = blockIdx.x; task < DEPTH * (6 * D / 32); task += GSIZE) { const int l = task / (6 * D / 32), n0 = (task % (6 * D / 32)) * 32, lane = LANE, ks = 2 * WAVE + (lane >> 5), cl = lane & 31;
              const GAS float* w = (const GAS float*)w_ada + ((size_t)l * D + ks * 64) * 6 * D + n0 + cl; float a[9];
#pragma unroll
              for (int j = 0; j < 9; ++j) a[j] = 0.f;
              for (int kc = 0; kc < 64; kc += 32) { float wv[32];
#pragma unroll
                  for (int k2 = 0; k2 < 32; ++k2) wv[k2] = w[(size_t)(kc + k2) * 6 * D];
#pragma unroll
                  for (int k4 = 0; k4 < 32; k4 += 4)
#pragma unroll
                      for (int j = 0; j < 9; ++j) { const f32x4 s4 = *(const LAS f32x4*)(sv + j * D + ks * 64 + kc + k4); a[j] += (s4[0] * wv[k4] + s4[1] * wv[k4 + 1]) + (s4[2] * wv[k4 + 2] + s4[3] * wv[k4 + 3]); } }
#pragma unroll
              for (int j = 0; j < 9; ++j) part[(ks * 9 + j) * 32 + cl] = a[j];
              __syncthreads();
              for (int e = TID; e < 9 * 32; e += NTHR) { const int j = e >> 5, ln = e & 31; float s = b_ada[(size_t)l * 6 * D + n0 + ln];
#pragma unroll
                  for (int q = 0; q < 16; ++q) s += part[(q * 9 + j) * 32 + ln];
                  WSP(float, WS_MODS)[((size_t)l * 9 + j) * 6 * D + n0 + ln] = s; }
              __syncthreads(); } }
        __syncthreads();
        LAS float* scr = (LAS float*)(lds + WAVE * 16384);
        constexpr int I_INE = (D / 128) * (IN_EVEN / 32), I_OUT = (MIXW / 128) * (D / 32), I_UQ = (Q_RANK / 128) * (QB_W / 32), I_UKV = (KV_RANK / 128) * (KV_W / 32), I_INO = (D / 128) * (IN_ODD / 32),
                      I_UP = (D / 128) * (2 * D_FF / 32), I_DN = (D_FF / 128) * (D / 32);
        constexpr int NITEMS = 2 * (I_INE + I_OUT + I_UQ + 2 * I_UKV + I_INO + I_OUT) + 4 * (I_UP + I_DN);
        for (int rt_ = 0; rt_ < REP_TR; ++rt_) GWAVES(it, NITEMS) {
            int r = (int)it; const int lane = LANE;
            if (r < 2 * I_INE) { const int li = r / I_INE, q = r % I_INE, nblk = IN_EVEN / 32, kb = q / nblk, sb = q % nblk, db = sb == 48 ? 66 : (sb > 48 ? sb - 1 : sb);
                p0_transpose_blk(w_in_even + (size_t)li * D * IN_EVEN, D, IN_EVEN, WSP(bf16, WS_WINE) + (size_t)li * IN_EVEN_P * D, scr, 128 * kb, 32 * sb, 32 * db, nullptr, lane); continue; } r -= 2 * I_INE;
            if (r < 2 * I_OUT) { const int li = r / I_OUT, q = r % I_OUT, nblk = D / 32; p0_transpose_blk(w_out_even + (size_t)li * MIXW * D, MIXW, D, WSP(bf16, WS_WOUTE) + (size_t)li * D * MIXW, scr, 128 * (q / nblk), 32 * (q % nblk), 32 * (q % nblk), nullptr, lane); continue; } r -= 2 * I_OUT;
            if (r < 2 * I_UQ) { const int li = r / I_UQ, q = r % I_UQ, nblk = QB_W / 32, kb = q / nblk, sb = q % nblk, hq = sb / 6, j = sb % 6, db = j < 4 ? 4 * hq + j : 16 + 2 * hq + (j - 4);
                p0_transpose_blk(mla_w_uq + (size_t)li * Q_RANK * QB_W, Q_RANK, QB_W, WSP(bf16, WS_WUQ) + (size_t)li * QB_W * Q_RANK, scr, 128 * kb, 32 * sb, 32 * db, mla_q_norm + (size_t)li * Q_RANK, lane); continue; } r -= 2 * I_UQ;
            if (r < 4 * I_UKV) { const int fold = r < 2 * I_UKV; const int r2 = fold ? r : r - 2 * I_UKV; const int li = r2 / I_UKV, q = r2 % I_UKV, nblk = KV_W / 32, kb = q / nblk, sb = q % nblk, hq = sb / 8, j = sb % 8, db = j < 4 ? 4 * hq + j : 16 + 4 * hq + (j - 4);
                p0_transpose_blk(mla_w_ukv + (size_t)li * KV_RANK * KV_W, KV_RANK, KV_W, WSP(bf16, fold ? WS_WUKV : WS_WUKVC) + (size_t)li * KV_W * KV_RANK, scr, 128 * kb, 32 * sb, 32 * db, fold ? mla_kv_norm + (size_t)li * KV_RANK : nullptr, lane); continue; } r -= 4 * I_UKV;
            if (r < 2 * I_INO) { const int li = r / I_INO, q = r % I_INO, nblk = IN_ODD / 32; p0_transpose_blk(w_in_odd + (size_t)li * D * IN_ODD, D, IN_ODD, WSP(bf16, WS_WINO) + (size_t)li * IN_ODD * D, scr, 128 * (q / nblk), 32 * (q % nblk), 32 * (q % nblk), nullptr, lane); continue; } r -= 2 * I_INO;
            if (r < 2 * I_OUT) { const int li = r / I_OUT, q = r % I_OUT, nblk = D / 32; p0_transpose_blk(w_out_odd + (size_t)li * MIXW * D, MIXW, D, WSP(bf16, WS_WOUTO) + (size_t)li * D * MIXW, scr, 128 * (q / nblk), 32 * (q % nblk), 32 * (q % nblk), nullptr, lane); continue; } r -= 2 * I_OUT;
            if (r < 4 * I_UP) { const int l = r / I_UP, q = r % I_UP, nblk = 2 * D_FF / 32, sb = q % nblk, hb = D_FF / 32, isg = sb >= hb, ab = isg ? sb - hb : sb, tail = ab >= UP_FULL_N / 64;
                const int drow = tail ? UP_FULL_N + 64 * (ab - UP_FULL_N / 64) : 32 * ((ab >> 2) * 8 + 4 * isg + (ab & 3));
                p0_transpose_blk(ffn_w_up + (size_t)l * D * 2 * D_FF, D, 2 * D_FF, WSP(bf16, WS_WUP) + (size_t)l * 2 * D_FF * D, scr, 128 * (q / nblk), 32 * sb, drow, nullptr, lane, tail ? 1 + isg : 0); continue; } r -= 4 * I_UP;
            { const int l = r / I_DN, q = r % I_DN, nblk = D / 32; p0_transpose_blk(ffn_w_down + (size_t)l * D_FF * D, D_FF, D, WSP(bf16, WS_WDN) + (size_t)l * D * D_FF, scr, 128 * (q / nblk), 32 * (q % nblk), 32 * (q % nblk), nullptr, lane); }
        }
        GTHREADS(i, (i64)2 * (IN_EVEN_P - IN_EVEN) * D) { const i64 per = (i64)(IN_EVEN_P - IN_EVEN) * D; WSP(bf16, WS_WINE)[(i / per) * IN_EVEN_P * D + (i64)IN_EVEN * D + i % per] = 0; }
        for (int rc_ = 0; rc_ < REP_CACHE; ++rc_) {
        { const i64 t0 = (i64)blockIdx.x * NTHR + TID, nthr = (i64)GSIZE * NTHR;
          p0_cache_copy(cache_mla_ckv, WSP(bf16, WS_CCKV), DEC_BATCH, N_EVEN, PAST * KV_RANK, t0, nthr);
          p0_cache_copy(cache_mla_krope, WSP(bf16, WS_KRC), DEC_BATCH, N_EVEN, PAST * ROPE, t0, nthr);
          p0_cache_copy(cache_diff_k, WSP(bf16, WS_KDC), DEC_BATCH, N_ODD, PAST * 1024, t0, nthr); }
        { const i64 nv = (i64)N_ODD * DEC_BATCH * H_C * 128 * (PAST / 8), nthr = (i64)GSIZE * NTHR;
          for (i64 i0 = (i64)blockIdx.x * NTHR + TID; i0 < nv; i0 += 2 * nthr) { float sv[2][8];
#pragma unroll
            for (int u = 0; u < 2; ++u) { const i64 i = i0 + u * nthr; if (i < nv) { const int dv = (int)(i % 128), hq = (int)((i / 128) % H_C), kb = (int)((i / (128 * H_C)) % (PAST / 8)); const i64 b = (i / (128 * H_C * (PAST / 8))) % DEC_BATCH, lq = i / ((i64)128 * H_C * (PAST / 8) * DEC_BATCH);
                const GAS float* src = (const GAS float*)cache_diff_v + ((b * N_ODD + lq) * PAST + 8 * kb) * 1024 + hq * 128 + dv;
#pragma unroll
                for (int k = 0; k < 8; ++k) sv[u][k] = src[1024 * k]; } }
#pragma unroll
            for (int u = 0; u < 2; ++u) { const i64 i = i0 + u * nthr; if (i < nv) { const int dv = (int)(i % 128), hq = (int)((i / 128) % H_C), kb = (int)((i / (128 * H_C)) % (PAST / 8)); const i64 b = (i / (128 * H_C * (PAST / 8))) % DEC_BATCH, lq = i / ((i64)128 * H_C * (PAST / 8) * DEC_BATCH);
                *(GAS v4u*)(WSP(bf16, WS_VDC) + (((lq * DEC_BATCH + b) * H_C + hq) * 128 + dv) * PAST + 8 * kb) = (v4u){pk2(sv[u][0], sv[u][1]), pk2(sv[u][2], sv[u][3]), pk2(sv[u][4], sv[u][5]), pk2(sv[u][6], sv[u][7])}; } } } }
        }
    }
    GRID_BAR();
    for (int rb_ = 0; rb_ < REP_P0B; ++rb_) {
        { const int combo = VCU & 7, l = combo >> 1, sub = combo & 1, slice = VCU >> 3, nsl = GSIZE >> 3, lane = LANE;
          float shr[9][16];
#pragma unroll
          for (int j = 0; j < 9; ++j) { const GAS f32x4* sp = (const GAS f32x4*)(WSP(float, WS_MODS) + ((size_t)l * 9 + j) * 6 * D + sub * 3 * D + lane * 16);
#pragma unroll
              for (int q = 0; q < 4; ++q) { const f32x4 t = sp[q]; shr[j][4 * q] = t[0]; shr[j][4 * q + 1] = t[1]; shr[j][4 * q + 2] = t[2]; shr[j][4 * q + 3] = t[3]; } }
          const int N = sub ? 2 * D_FF : ((l & 1) ? IN_ODD : IN_EVEN_P);
          const bf16* Wt = sub ? WSP(bf16, WS_WUP) + (size_t)l * 2 * D_FF * D : ((l & 1) ? WSP(bf16, WS_WINO) + (size_t)(l >> 1) * IN_ODD * D : WSP(bf16, WS_WINE) + (size_t)(l >> 1) * IN_EVEN_P * D);
          float* dst = WSP(float, WS_SHW) + (size_t)(l * 2 + sub) * 9 * 2 * D_FF;
          for (int n0 = slice * NWAVES + WAVE; n0 < N; n0 += 2 * nsl * NWAVES) {
              const int n1 = n0 + nsl * NWAVES, n1c = n1 < N ? n1 : n0;
              const v4u wa0 = *(const GAS v4u*)(Wt + (size_t)n0 * D + lane * 16), wa1 = *(const GAS v4u*)(Wt + (size_t)n0 * D + lane * 16 + 8), wb0 = *(const GAS v4u*)(Wt + (size_t)n1c * D + lane * 16), wb1 = *(const GAS v4u*)(Wt + (size_t)n1c * D + lane * 16 + 8);
#pragma unroll
              for (int u = 0; u < 2; ++u) { const v4u w0 = u ? wb0 : wa0, w1 = u ? wb1 : wa1; const int n = u ? n1 : n0;
                  float wv[16];
#pragma unroll
                  for (int q = 0; q < 4; ++q) { wv[2 * q] = bflo(w0[q]); wv[2 * q + 1] = bfhi(w0[q]); wv[8 + 2 * q] = bflo(w1[q]); wv[8 + 2 * q + 1] = bfhi(w1[q]); }
#pragma unroll
                  for (int j = 0; j < 9; ++j) { float sacc = 0.f;
#pragma unroll
                      for (int q = 0; q < 16; ++q) sacc += wv[q] * shr[j][q];
                      sacc = wave_sum_l63(sacc); if (lane == 63 && n < N) ((GAS float*)dst)[(size_t)j * 2 * D_FF + n] = sacc; } }
          } }
        GTHREADS(i, (i64)DEPTH * 2 * 9 * D) { const int c = (int)(i % D), j = (int)((i / D) % 9), dn = (int)((i / (9 * D)) & 1), l = (int)(i / (18 * D)), ln = l + 1 < DEPTH ? l + 1 : l;
            const float g = norm_gain[(size_t)(dn ? ln * 2 : l * 2 + 1) * D + c], sc = dn ? WSP(float, WS_MODS)[((size_t)ln * 9 + j) * 6 * D + D + c] : WSP(float, WS_MODS)[((size_t)l * 9 + j) * 6 * D + 4 * D + c];
            WSP(float, WS_GS)[i] = g * (1.f + sc); }
        { const int lane2 = LANE; f32x4 gq[4];
#pragma unroll
          for (int q = 0; q < 4; ++q) gq[q] = *(const GAS f32x4*)(norm_gain + 256 * q + 4 * lane2);
          for (i64 row0 = (i64)blockIdx.x * NWAVES + WAVE; row0 < M_ALL; row0 += (i64)4 * GSIZE * NWAVES) { f32x4 x[4][4], sc[4][4];
#pragma unroll
            for (int u = 0; u < 4; ++u) { const i64 row = row0 + (i64)u * GSIZE * NWAVES; const float* xr = row < M_CTX ? x_prompt + (size_t)row * D : x_sample + (size_t)(row - M_CTX) * D; const int mj = row < M_CTX ? 0 : 1 + (int)((row - M_CTX) >> 10);
                const float* scv = WSP(float, WS_MODS) + (size_t)mj * 6 * D + D;
#pragma unroll
                for (int q = 0; q < 4; ++q) { x[u][q] = *(const GAS f32x4*)(xr + 256 * q + 4 * lane2); sc[u][q] = *(const GAS f32x4*)(scv + 256 * q + 4 * lane2); } }
#pragma unroll
            for (int u = 0; u < 4; ++u) { const i64 row = row0 + (i64)u * GSIZE * NWAVES; float s = 0.f;
#pragma unroll
                for (int q = 0; q < 4; ++q) { const f32x4 xv = x[u][q]; s += (xv[0] * xv[0] + xv[1] * xv[1]) + (xv[2] * xv[2] + xv[3] * xv[3]); *(GAS v2u*)(WSP(bf16, WS_XG) + (size_t)row * D + 256 * q + 4 * lane2) = epi::pk4(xv * (gq[q] * (sc[u][q] + 1.f))); }
                s = wave_sum(s); if (lane2 < 16) WSP(float, WS_SSQ)[(size_t)row * 16 + lane2] = lane2 == 0 ? s : 0.f; } } }
        for (int li = 0; li < N_EVEN; ++li) { epi::EpiKV<1> E{lds, li};
            GEMM_SUB(E, WSP(bf16, WS_CCKV) + (size_t)li * CROWS * KV_RANK, KV_RANK, WSP(bf16, WS_WUKVC) + (size_t)li * KV_W * KV_RANK, KV_RANK, CROWS, KV_W, KV_RANK, 64 * li, 64); }
    }
    GRID_BAR();

    for (int l = 0; l < DEPTH; ++l) {
        const int li = l >> 1;
        if ((l & 1) == 0) {
            for (int rep_ = 0; rep_ < REP_IN; ++rep_) { epi::EpiInE<false> E{lds, li, l, 0};
              GEMM_RS(E, WSP(float, WS_SSQ), WSP(float, WS_SHW) + (size_t)(l * 2) * 9 * 2 * D_FF, WSP(bf16, WS_XG), D, WSP(bf16, WS_WINE) + (size_t)li * IN_EVEN_P * D, D, M_ALL, 2048, D); }
            GRID_BAR();
            { epi::EpiInE<true> E{lds, li, l, 8}; int k_ = D; asm volatile("" : "+s"(k_));
              const pg8::Gemm g_{(const pg8::bf16_t*)WSP(bf16, WS_XG), (const pg8::bf16_t*)(WSP(bf16, WS_WINE) + ((size_t)li * IN_EVEN_P + 2048) * D), M_ALL, 128, k_, D, D};
              int G_ = 64, c_ = (int)blockIdx.x; if (c_ >= G_) c_ = -1; asm volatile("" : "+s"(G_), "+s"(c_));
              pg8::StaticOrder S_; S_.init(M_ALL, 256, G_, c_); epi::rstd_prepass<16, 1>(lds, WSP(float, WS_SSQ), S_, 1.f / D, WSP(float, WS_SHW) + (size_t)(l * 2) * 9 * 2 * D_FF, 8);
              pg8::gemm_phase<decltype(E), pg8::StaticOrder, true, true, 1>(lds, g_, S_, E); }
            { int G_ = GSIZE - 64, c_ = (int)blockIdx.x - 64; if (c_ >= G_) c_ = -1; asm volatile("" : "+s"(G_), "+s"(c_));
              pg8::StaticOrder Sq_, Skv_; Sq_.init(M_ALL, QB_W, G_, c_); Skv_.init(M_ALL, KV_W, G_, c_);
              epi::rstd_prepass<4, 1>(lds, WSP(float, WS_SSQC), Sq_, 1.f / Q_RANK, nullptr, 0, 0, false);
              epi::rstd_prepass<4, 2>(lds, WSP(float, WS_SSQC) + (size_t)M_ALL * 4, Skv_, 1.f / KV_RANK, nullptr, 0, 2, true); }
            for (int rep_ = 0; rep_ < REP_E2; ++rep_) { epi::EpiUq E{lds}; GEMM_SUB(E, WSP(bf16, WS_PBE) + 1536, PBE_W, WSP(bf16, WS_WUQ) + (size_t)li * QB_W * Q_RANK, Q_RANK, M_ALL, QB_W, Q_RANK, 64, GSIZE - 64); }
            for (int rep_ = 0; rep_ < REP_E2; ++rep_) { epi::EpiKV<0> E{lds, li}; GEMM_SUB(E, WSP(bf16, WS_PBE) + 1792, PBE_W, WSP(bf16, WS_WUKV) + (size_t)li * KV_W * KV_RANK, KV_RANK, M_ALL, KV_W, KV_RANK, 64, GSIZE - 64); }
            { const int lane = LANE; const f32x4 kg = *(const GAS f32x4*)(mla_kv_norm + (size_t)li * KV_RANK + 4 * lane);
              for (i64 row0 = (i64)blockIdx.x * NWAVES + WAVE; row0 < M_CTX; row0 += (i64)4 * GSIZE * NWAVES) { f32x4 ov[4], pq[4];
#pragma unroll
                for (int u = 0; u < 4; ++u) { const i64 row = row0 + (i64)u * GSIZE * NWAVES; ov[u] = *(const GAS f32x4*)(o_ckv + (((size_t)(row >> 8) * N_EVEN + li) * SEQ + (row & 255)) * KV_RANK + 4 * lane); pq[u] = *(const GAS f32x4*)(WSP(float, WS_SSQC) + ((size_t)M_ALL + row) * 4); }
#pragma unroll
                for (int u = 0; u < 4; ++u) { const i64 row = row0 + (i64)u * GSIZE * NWAVES; const float rstd = __builtin_amdgcn_rsqf(((pq[u][0] + pq[u][1]) + (pq[u][2] + pq[u][3])) * (1.f / KV_RANK) + EPS);
                    *(GAS f32x4*)(o_ckv + (((size_t)(row >> 8) * N_EVEN + li) * SEQ + (row & 255)) * KV_RANK + 4 * lane) = ov[u] * rstd * kg; } } }
            GRID_BAR();
            for (int rep_ = 0; rep_ < REP_E3; ++rep_) { const int v = VCU;
              const int ng = v < 128 ? 0 : (v < 192 ? 1 : 4);
              for (int rg_ = 0; rg_ < REP_GLA; ++rg_) for (int q = 0; q < ng; ++q) {
                  const int g = v < 192 ? v - 128 : 4 * (v - 192) + q; const int B = v < 192 ? BATCH + (g >> 3) : (g >> 3), h = (g >> 1) & 3, dir = g & 1;
                  const int lat = B >= BATCH, bl = B - BATCH, T = lat ? DEC_SEQ : SEQ, row0 = lat ? M_CTX + bl * DEC_SEQ : B * SEQ;
                  const float* s0 = lat ? state_gla + ((((size_t)bl * N_EVEN + li) * 2 + dir) * H_A + h) * DK_A * DV_A : nullptr;
                  float* so = lat ? nullptr : o_state + ((((size_t)B * N_EVEN + li) * 2 + dir) * H_A + h) * DK_A * DV_A;
                  bf16* out = dir ? WSP(bf16, WS_OGB) + h * DV_A : WSP(bf16, WS_MIX) + h * DV_A;
                  for (int rl_ = 0; rl_ < REP_LD; ++rl_) gla::ld_unit(WSP(float, WS_LR), WSP(float, WS_LD), row0, T, h, dir, gla_w_decay + ((size_t)li * 2 + dir) * GLA_LR * 256, gla_b_decay + ((size_t)li * 2 + dir) * 256);
                  gla::gla_unit(lds, WSP(bf16, WS_PBE), WSP(float, WS_LD), row0, T, h, dir, s0, so, out, dir ? 512 : MIXW); }
              if (v >= 192) { VM_WAIT(); __syncthreads(); const int vv = v - 192;
                  gla_combine(WSP(bf16, WS_MIX), WSP(bf16, WS_OGB), WSP(bf16, WS_PBE), gla_norm + (size_t)li * DV_A, (vv >> 1) * SEQ, SEQ, (2 * vv) & 3, 2, WAVE, LANE); }
              else if (v >= 128) { const int g = v - 128, bl = g >> 3, h = (g >> 1) & 3, dir = g & 1;
                  VM_WAIT(); __syncthreads();
                  if (TID == 0) { unsigned* pc = (unsigned*)((gu32*)(WSB + WS_CTL) + CW_PAIR + li * 32 + (g >> 1)); const unsigned target = 2u * (unsigned)(rep_ + 1);
                      __builtin_amdgcn_fence(__ATOMIC_RELEASE, "agent"); VM_WAIT();
                      (void)xb_add(pc, 1u); XB_SPIN(xb_ld(pc) < target, (unsigned*)((gu32*)(WSB + WS_CTL) + CW_BAR));
                      __builtin_amdgcn_fence(__ATOMIC_ACQUIRE, "agent"); VM_WAIT(); }
                  __syncthreads();
                  gla_combine(WSP(bf16, WS_MIX), WSP(bf16, WS_OGB), WSP(bf16, WS_PBE), gla_norm + (size_t)li * DV_A, M_CTX + bl * DEC_SEQ + dir * (DEC_SEQ / 2), DEC_SEQ / 2, h, 1, WAVE, LANE); }
              for (int rm2_ = 0; rm2_ < (v < 128 ? 2 * REP_MLA : 0); ++rm2_) { const int ctx = (rm2_ + (((int)blockIdx.x >> 3) & 1)) & 1;
                const int B = ctx ? (v >> 2) : BATCH + (v >> 4), h = ctx ? v & 3 : (v >> 2) & 3, qt = ctx ? 0 : v & 3;
                const int lat = B >= BATCH, bl = B - BATCH, T = lat ? DEC_SEQ : SEQ, row0 = lat ? M_CTX + bl * DEC_SEQ : B * SEQ;
                attn::KSrc cs{WSP(bf16, WS_KNC) + ((size_t)li * CROWS + (size_t)bl * PAST) * 512 + h * 128, WSP(bf16, WS_KRC) + ((size_t)li * CROWS + (size_t)bl * PAST) * ROPE, WSP(bf16, WS_VTC) + ((size_t)li * CROWS + (size_t)bl * PAST) * 512 + (size_t)h * 128 * PAST, 512, ROPE, PAST, 0};
                attn::KSrc ns{WSP(bf16, WS_KN) + (size_t)row0 * 512 + h * 128, WSP(bf16, WS_KR) + (size_t)row0 * ROPE, WSP(bf16, WS_VT) + (size_t)row0 * 512 + (size_t)h * 128 * T, 512, ROPE, T, 0};
                const bf16* q = WSP(bf16, WS_QBUF) + (size_t)(row0 + 256 * qt) * QB_W;
                attn::attn_unit<192>(lds, q + h * 128, q + 512 + h * 64, QB_W, cs, lat ? PAST / 64 : 0, ns, T / 64, WSP(bf16, WS_MIX) + (size_t)(row0 + 256 * qt) * MIXW + 512 + h * 128, MIXW); } }
            GRID_BAR();
        } else {
            for (int rep_ = 0; rep_ < REP_IN; ++rep_) { epi::EpiInO E{lds, li, l};
              GEMM_RS(E, WSP(float, WS_SSQ), WSP(float, WS_SHW) + (size_t)(l * 2) * 9 * 2 * D_FF, WSP(bf16, WS_XG), D, WSP(bf16, WS_WINO) + (size_t)li * IN_ODD * D, D, M_ALL, IN_ODD, D); }
            GRID_BAR();
            for (int rep_ = 0; rep_ < REP_O3; ++rep_) { const int v = VCU, lane = LANE; const float* lp = diff_lambda + (size_t)li * 4 * DH_C; const float lam_init = 0.8f - 0.6f * __expf(-0.3f * (float)l);
              const float lam = __expf(wave_sum(lp[lane] * lp[DH_C + lane])) - __expf(wave_sum(lp[2 * DH_C + lane] * lp[3 * DH_C + lane])) + lam_init;
              const int ctx_first = ((int)blockIdx.x >> 3) & 1;
              for (int rep0 = 0; rep0 < 4; ++rep0) { const int rep = (rep0 + 2 * ctx_first) & 3;
                  const int lat = rep < 2, map = rep & 1;
                  const int B = lat ? BATCH + (v >> 5) : (v >> 3), h = lat ? (v >> 2) & 7 : v & 7, qt = lat ? v & 3 : 0;
                  const int bl = B - BATCH, T = lat ? DEC_SEQ : SEQ, row0 = lat ? M_CTX + bl * DEC_SEQ : B * SEQ;
                  attn::KSrc cs{WSP(bf16, WS_KDC) + ((size_t)li * CROWS + (size_t)bl * PAST) * 1024 + h * 128 + map * 64, nullptr, WSP(bf16, WS_VDC) + ((size_t)li * CROWS + (size_t)bl * PAST) * 1024 + (size_t)h * 128 * PAST, 1024, 0, PAST, 0};
                  attn::KSrc ns{WSP(bf16, WS_PBO) + (size_t)row0 * PBO_W + 1024 + h * 128 + map * 64, nullptr, WSP(bf16, WS_VD) + (size_t)row0 * 1024 + (size_t)h * 128 * T, PBO_W, 0, T, 0};
                  const bf16* q = WSP(bf16, WS_PBO) + (size_t)(row0 + 256 * qt) * PBO_W + h * 128 + map * 64; bf16* o = WSP(bf16, WS_MIX) + (size_t)(row0 + 256 * qt) * MIXW + h * 128;
                  if (map == 0) attn::attn_unit<64, false>(lds, q, nullptr, PBO_W, cs, lat ? PAST / 64 : 0, ns, T / 64, o, MIXW);
                  else attn::attn_unit<64, true>(lds, q, nullptr, PBO_W, cs, lat ? PAST / 64 : 0, ns, T / 64, o, MIXW, lam, 1.f - lam_init, diff_norm + (size_t)li * 128); } }
            GRID_BAR();
        }
        if (l == 0) { epi::EpiOut<true> E{lds, l, 0, 0};
          GEMM(E, WSP(bf16, WS_MIX), MIXW, ((l & 1) ? WSP(bf16, WS_WOUTO) : WSP(bf16, WS_WOUTE)) + (size_t)li * D * MIXW, MIXW, M_ALL, D, MIXW); }
        else { epi::EpiOut<false> E{lds, l, 0, 0};
          GEMM(E, WSP(bf16, WS_MIX), MIXW, ((l & 1) ? WSP(bf16, WS_WOUTO) : WSP(bf16, WS_WOUTE)) + (size_t)li * D * MIXW, MIXW, M_ALL, D, MIXW); }
        GRID_BAR();
        for (int rep_ = 0; rep_ < REP_UP; ++rep_) { int tail_first = ((int)blockIdx.x >> 3) & 1; asm volatile("" : "+s"(tail_first));
          { pg8::StaticOrder S0_; S0_.init(M_ALL, UP_FULL_N, GSIZE, (int)blockIdx.x); epi::rstd_prepass<16, 1>(lds, WSP(float, WS_SSQ) + (size_t)M_ALL * 16, S0_, 1.f / D); }
          if (tail_first) {
          { epi::EpiUpConv<true> E{lds, l}; int k_ = D; asm volatile("" : "+s"(k_));
            const pg8::Gemm g_{(const pg8::bf16_t*)WSP(bf16, WS_XG), (const pg8::bf16_t*)(WSP(bf16, WS_WUP) + ((size_t)l * 2 * D_FF + UP_FULL_N) * D), M_ALL, 2 * D_FF - UP_FULL_N, k_, D, D};
            int G_ = GSIZE, c_ = (int)blockIdx.x; asm volatile("" : "+s"(G_), "+s"(c_));
            pg8::StaticOrder S_; S_.init(M_ALL, 2 * (2 * D_FF - UP_FULL_N), G_, c_);
            pg8::gemm_phase<decltype(E), pg8::StaticOrder, true, true, 1>(lds, g_, S_, E); } }
            { epi::EpiUpConv<false> E{lds, l}; GEMM(E, WSP(bf16, WS_XG), D, WSP(bf16, WS_WUP) + (size_t)l * 2 * D_FF * D, D, M_ALL, UP_FULL_N, D); }
          if (!tail_first) {
          { epi::EpiUpConv<true> E{lds, l}; int k_ = D; asm volatile("" : "+s"(k_));
            const pg8::Gemm g_{(const pg8::bf16_t*)WSP(bf16, WS_XG), (const pg8::bf16_t*)(WSP(bf16, WS_WUP) + ((size_t)l * 2 * D_FF + UP_FULL_N) * D), M_ALL, 2 * D_FF - UP_FULL_N, k_, D, D};
            int G_ = GSIZE, c_ = (int)blockIdx.x; asm volatile("" : "+s"(G_), "+s"(c_));
            pg8::StaticOrder S_; S_.init(M_ALL, 2 * (2 * D_FF - UP_FULL_N), G_, c_);
            pg8::gemm_phase<decltype(E), pg8::StaticOrder, true, true, 1>(lds, g_, S_, E); } } }
        GRID_BAR();
        { const float* cw = ffn_conv_w + (size_t)l * 3 * 2 * D_FF; const float* cb = ffn_conv_b + (size_t)l * 2 * D_FF;
          pg8::StaticOrder Sd; Sd.init(M_ALL, D, GSIZE, (int)blockIdx.x); pg8::Unit ud; ud.pm = 0; ud.pn = 0; ud.idx = 0;
          if (Sd.next(0, ud)) { const int pm = ud.pm;
          const int inseq = pm >= 32, ps = inseq ? (pm - 32) & 3 : 0;
          const size_t RW = 2 * D_FF; const f32x4 z = {0.f, 0.f, 0.f, 0.f};
          for (int i0 = TID; i0 < D_FF / 4; i0 += NTHR) { const int f = i0 * 4;
              const GAS float* ub = (const GAS float*)WSP(float, WS_UB) + (size_t)pm * 8 * 2 * D_FF + f;
              f32x4 C[8], UA[10], UG[10];
              C[0] = *(const GAS f32x4*)(cb + f); C[1] = *(const GAS f32x4*)(cw + f); C[2] = *(const GAS f32x4*)(cw + 2 * D_FF + f); C[3] = *(const GAS f32x4*)(cw + 4 * D_FF + f);
              C[4] = *(const GAS f32x4*)(cb + D_FF + f); C[5] = *(const GAS f32x4*)(cw + D_FF + f); C[6] = *(const GAS f32x4*)(cw + 3 * D_FF + f); C[7] = *(const GAS f32x4*)(cw + 5 * D_FF + f);
              const bool hasp0 = inseq && ps != 0, hasn3 = inseq && ps != 3;
#pragma unroll
              for (int sidx = 0; sidx < 10; ++sidx) { const int slot = sidx - 1; const bool need = slot == -1 ? hasp0 : (slot == 8 ? hasn3 : true);
                  if (need) { UA[sidx] = *(const GAS f32x4*)(ub + (ptrdiff_t)slot * (ptrdiff_t)RW); UG[sidx] = *(const GAS f32x4*)(ub + (ptrdiff_t)slot * (ptrdiff_t)RW + D_FF); } else { UA[sidx] = z; UG[sidx] = z; } }
#pragma unroll
              for (int q = 0; q < 4; ++q) { const int sc = q == 0 ? 0 : (q == 1 ? 3 : (q == 2 ? 4 : 7)), t = q == 0 ? 0 : (q == 1 ? 127 : (q == 2 ? 128 : 255));
                  const f32x4 ca = C[0] + C[1] * UA[sc] + C[2] * UA[sc + 1] + C[3] * UA[sc + 2], cg = C[4] + C[5] * UG[sc] + C[6] * UG[sc + 1] + C[7] * UG[sc + 2];
                  *(GAS v2u*)(WSP(bf16, WS_ACT) + ((size_t)pm * 256 + t) * D_FF + f) = (v2u){pk2(silu_f(ca[0]) * cg[0], silu_f(ca[1]) * cg[1]), pk2(silu_f(ca[2]) * cg[2], silu_f(ca[3]) * cg[3])}; } } }
          VM_WAIT(); __syncthreads(); { unsigned o_ = 0; asm volatile("" : "+s"(o_)); lds = lds0 + o_; } }
        { epi::EpiOut<false> E{lds, l, 1, 0};
          GEMM(E, WSP(bf16, WS_ACT), D_FF, WSP(bf16, WS_WDN) + (size_t)l * D * D_FF, D_FF, M_ALL, D, D_FF); }
        GRID_BAR();
    }
    for (int rep_ = 0; rep_ < REP_BAR; ++rep_) GRID_BAR();
    { const int lane = LANE; f32x4 fg[4];
#pragma unroll
      for (int q = 0; q < 4; ++q) fg[q] = *(const GAS f32x4*)(final_gain + 256 * q + 4 * lane);
      for (i64 row0 = (i64)blockIdx.x * NWAVES + WAVE; row0 < M_ALL; row0 += (i64)4 * GSIZE * NWAVES) { v2u w[4][4]; f32x4 pq[4][4];
#pragma unroll
        for (int u = 0; u < 4; ++u) { const i64 row = row0 + (i64)u * GSIZE * NWAVES; const bf16* xr = WSP(bf16, WS_X) + (size_t)row * D;
#pragma unroll
            for (int q = 0; q < 4; ++q) { w[u][q] = *(const GAS v2u*)(xr + 256 * q + 4 * lane); pq[u][q] = *(const GAS f32x4*)(WSP(float, WS_SSQ) + (size_t)row * 16 + 4 * q); } }
#pragma unroll
        for (int u = 0; u < 4; ++u) { const i64 row = row0 + (i64)u * GSIZE * NWAVES; float* y = (row < M_CTX ? o_y_prompt + (size_t)row * D : o_y_sample + (size_t)(row - M_CTX) * D);
            const f32x4 sa = (pq[u][0] + pq[u][1]) + (pq[u][2] + pq[u][3]); const float rstd = __builtin_amdgcn_rsqf(((sa[0] + sa[1]) + (sa[2] + sa[3])) * (1.f / D) + EPS);
#pragma unroll
            for (int q = 0; q < 4; ++q) *(GAS f32x4*)(y + 256 * q + 4 * lane) = (f32x4){bflo(w[u][q].x), bfhi(w[u][q].x), bflo(w[u][q].y), bfhi(w[u][q].y)} * rstd * fg[q]; } } }
}

static int mk_launch(void* const* d_in, void* d_out, void* d_ws, size_t ws_size, hipStream_t stream) {
    static int grid = 0;
    if (grid == 0) {
        int dev = 0, cus = 0, per_cu = 0;
        if (hipGetDevice(&dev) != hipSuccess || hipDeviceGetAttribute(&cus, hipDeviceAttributeMultiprocessorCount, dev) != hipSuccess) { fprintf(stderr, "kernel_launch: device query failed\n"); grid = -1; return -1; }
        if (hipFuncSetAttribute((const void*)mk_fwd, hipFuncAttributeMaxDynamicSharedMemorySize, LDS_BYTES) != hipSuccess) { fprintf(stderr, "kernel_launch: hipFuncSetAttribute failed\n"); grid = -1; return -1; }
        if (hipOccupancyMaxActiveBlocksPerMultiprocessor(&per_cu, (const void*)mk_fwd, NTHR, LDS_BYTES) != hipSuccess || per_cu < 1) { fprintf(stderr, "kernel_launch: occupancy query says %d\n", per_cu); per_cu = 1; }
        (void)hipGetLastError();
        grid = cus;
        if (grid != 256) { fprintf(stderr, "kernel_launch: built for 256 CUs, found %d\n", cus); grid = -1; return -1; }
        if (ws_size < WS_END) { fprintf(stderr, "kernel_launch: workspace too small (%zu < %zu)\n", ws_size, (size_t)WS_END); grid = -1; return -1; }
    }
    if (grid < 0) return -1;
    (void)hipMemsetAsync((char*)d_ws + WS_CTL, 0, ZERO_BYTES, stream);
    Args a{};
    for (int i = 0; i < 30; ++i) a.in[i] = (const float*)d_in[i];
    a.out = (float*)d_out; a.ws = (unsigned char*)d_ws;
    void* kargs[] = {&a};
    hipError_t e = hipLaunchCooperativeKernel((const void*)mk_fwd, dim3(grid), dim3(NTHR), kargs, LDS_BYTES, stream);
    if (e != hipSuccess) { fprintf(stderr, "kernel_launch: cooperative launch failed: %s (grid %d)\n", hipGetErrorString(e), grid); return -1; }
    return 0;
}

extern "C" void kernel_launch(void* const* d_in, const int* in_sizes, int n_in, void* d_out, int out_size, void* d_ws, size_t ws_size, hipStream_t stream) {
    (void)in_sizes; (void)n_in; (void)out_size;
    mk_launch(d_in, d_out, d_ws, ws_size, stream);
}
```

```cpp
#include <hip/hip_runtime.h>
#include <cstdio>
#include <cstdint>
#include <cmath>
namespace pg8 {
#define PG8_LAS __attribute__((address_space(3)))
typedef unsigned short bf16_t;
typedef short bf16x8 __attribute__((ext_vector_type(8)));
typedef float f32x4 __attribute__((ext_vector_type(4)));
typedef unsigned u32x4 __attribute__((ext_vector_type(4)));
constexpr int BM = 256, BK = 64, HALF = 128, HTB = HALF * BK * 2  , STAGE_BYTES = 8 * HTB, NXCD = 8, WGM = 8;

__host__ __device__ __forceinline__ int lds_byte(int r, int c) { const int st = (r >> 4) * 2 + (c >> 5), rr = r & 15, cc = c & 31, ob = rr * 64 + cc * 2; return st * 1024 + (ob ^ (((ob >> 9) & 1) << 5)); }
__host__ __device__ __forceinline__ void stage_rc(int b, int& R, int& C) { const int st = b / 1024, sb = b % 1024, swz = sb ^ (((sb >> 9) & 1) << 5); R = (st >> 1) * 16 + swz / 64; C = (st & 1) * 32 + (swz % 64) / 2; }
__host__ __device__ __forceinline__ int perm32(int rho) { const int n = rho >> 4, i = rho & 15; return 8 * (i >> 2) + 4 * n + (i & 3); }

struct Unit { int pm, pn, idx; };
struct Gemm { const bf16_t* A; const bf16_t* Bt; int M, N, K, lda, ldb; };

struct StaticOrder {
    int nM, nN, nwg, G, c;
    __host__ __device__ __forceinline__ void init(int M, int N, int G_, int c_) { nM = M / BM; nN = N / BM; nwg = nM * nN; G = G_; c = c_; }
    __host__ __device__ __forceinline__ bool next(int i, Unit& u) const {
        if (c < 0) return false;
        const long L = (long)i * G + c; if (L >= nwg) return false;
        int wgid = (int)L; { const int q = nwg / NXCD, r = nwg % NXCD, xcd = wgid % NXCD, off = wgid / NXCD; wgid = (xcd < r ? xcd * (q + 1) : r * (q + 1) + (xcd - r) * q) + off; }
        const int nig = WGM * nN, gid = wgid / nig, fm = gid * WGM, gsz = (nM - fm) < WGM ? (nM - fm) : WGM;
        u.pm = fm + ((wgid % nig) % gsz); u.pn = (wgid % nig) / gsz; return true;
    }
    __device__ __forceinline__ void a_ready(const Unit&) const {}
    __device__ __forceinline__ void done(const Unit&) const {}
};

template <class Epi, class Sched, bool ALIGN_EPI = false, bool SP2 = false, int NB = 2>
__device__ __forceinline__ void gemm_phase(PG8_LAS unsigned char* lds, const Gemm g, const Sched& S, const Epi& E) {
    int tid_ = threadIdx.x; asm volatile("" : "+v"(tid_));
    const int tid = tid_, wid = __builtin_amdgcn_readfirstlane(tid >> 6), lane = tid & 63, wr = wid >> 2, wc = wid & 3, fr = lane & 15, fq = lane >> 4;
    const int K = g.K, nt = K / BK;
    unsigned voffA[2], voffB[2];
#pragma unroll
    for (int i = 0; i < 2; ++i) { int R, C; stage_rc(tid * 16 + i * 8192, R, C); const int Rb = Epi::PERM ? ((R & ~31) + perm32(R & 31)) : R;
        const int Ra = Epi::AROWPERM ? (128 * (R >> 6) + 8 * (R & 15) + ((R >> 4) & 3)) : R;
        voffA[i] = (unsigned)(Ra * g.lda + C) * 2u; voffB[i] = (unsigned)(Rb * g.ldb + C) * 2u; }
    const size_t kstep = (size_t)(BK * 2);
    const size_t hstepA = (size_t)(Epi::AROWPERM ? 4 : HALF) * g.lda * 2, hstepB = (size_t)HALF * g.ldb * 2;
    static_assert(NB == 2 || SP2, "NB = 1 is written for the SP2 loop only");
    const size_t tstepA = (size_t)2 * HALF * g.lda * 2, tstepB = NB * hstepB;
    const unsigned ldsw = (unsigned)wid * 1024u;
    const int aoff = lds_byte(wr * 64 + fr, fq * 8), boff = lds_byte(wc * 32 + fr, fq * 8);
#define PG8_SA(b, h) (((b) * 2 + (h)) * HTB)
#define PG8_SB(b, h) ((4 + (b) * 2 + (h)) * HTB)
#define PG8_STAGE(bufoff, gbase, voff) do { _Pragma("unroll") for (int _i = 0; _i < 2; ++_i) \
        __builtin_amdgcn_global_load_lds((const unsigned*)((const char*)(gbase) + (voff)[_i]), (PG8_LAS unsigned*)(lds + (bufoff) + ldsw + _i * 8192), 16, 0, 0); } while (0)
#define PG8_LDA(dst, b, h) do { _Pragma("unroll") for (int m = 0; m < 4; ++m) _Pragma("unroll") for (int k = 0; k < 2; ++k) dst[m][k] = *(const PG8_LAS bf16x8*)(lds + PG8_SA(b, h) + aoff + m * 2048 + k * 1024); } while (0)
#define PG8_LDB(dst, b, h) do { _Pragma("unroll") for (int n = 0; n < 2; ++n) _Pragma("unroll") for (int k = 0; k < 2; ++k) dst[n][k] = *(const PG8_LAS bf16x8*)(lds + PG8_SB(b, h) + boff + n * 2048 + k * 1024); } while (0)
#define PG8_MMA(ai, bj, At, Bt) do { __builtin_amdgcn_s_setprio(1); _Pragma("unroll") for (int m = 0; m < 4; ++m) _Pragma("unroll") for (int n = 0; n < 2; ++n) _Pragma("unroll") for (int k = 0; k < 2; ++k) \
        acc[ai][bj][m][n] = __builtin_amdgcn_mfma_f32_16x16x32_bf16(Bt[n][k], At[m][k], acc[ai][bj][m][n], 0, 0, 0); __builtin_amdgcn_s_setprio(0); } while (0)
#define PG8_WAIT_V(n) asm volatile("s_waitcnt vmcnt(" #n ")" ::: "memory")
#define PG8_WAIT_L(n) asm volatile("s_waitcnt lgkmcnt(" #n ")" ::: "memory")
#define PG8_BAR __builtin_amdgcn_s_barrier()
#define PG8_SCHED __builtin_amdgcn_sched_barrier(0)
    Unit cur, nxt; int ui = 0;
    if (!S.next(0, cur)) return;
    cur.idx = 0;
    f32x4 acc[2][2][4][2];
#pragma unroll
    for (int a = 0; a < 2; ++a)
#pragma unroll
        for (int b = 0; b < 2; ++b)
#pragma unroll
            for (int m = 0; m < 4; ++m)
#pragma unroll
                for (int n = 0; n < 2; ++n) acc[a][b][m][n] = (f32x4){0.f, 0.f, 0.f, 0.f};
    bf16x8 At[4][2], B0[2][2], B1[2][2];
    const char* cA = (const char*)g.A + (size_t)cur.pm * tstepA; const char* cB = (const char*)g.Bt + (size_t)cur.pn * tstepB;
    S.a_ready(cur);
    if constexpr (SP2 && NB == 1) {
        PG8_STAGE(PG8_SB(0, 0), cB, voffB); PG8_STAGE(PG8_SA(0, 0), cA, voffA); PG8_STAGE(PG8_SA(0, 1), cA + hstepA, voffA);
        if (wr == 1) PG8_BAR;
        PG8_WAIT_V(2); PG8_BAR;
        PG8_STAGE(PG8_SB(1, 0), cB + kstep, voffB); PG8_STAGE(PG8_SA(1, 0), cA + kstep, voffA);
        PG8_WAIT_V(4); PG8_BAR;
    } else if constexpr (SP2) {
        PG8_STAGE(PG8_SB(0, 0), cB, voffB); PG8_STAGE(PG8_SB(0, 1), cB + hstepB, voffB); PG8_STAGE(PG8_SA(0, 0), cA, voffA); PG8_STAGE(PG8_SA(0, 1), cA + hstepA, voffA);
        if (wr == 1) PG8_BAR;
        PG8_WAIT_V(2); PG8_BAR;
        PG8_STAGE(PG8_SB(1, 0), cB + kstep, voffB); PG8_STAGE(PG8_SA(1, 0), cA + kstep, voffA); PG8_STAGE(PG8_SB(1, 1), cB + hstepB + kstep, voffB);
        PG8_WAIT_V(6); PG8_BAR;
    } else {
        PG8_STAGE(PG8_SB(0, 0), cB, voffB); PG8_STAGE(PG8_SA(0, 0), cA, voffA); PG8_STAGE(PG8_SB(0, 1), cB + hstepB, voffB); PG8_STAGE(PG8_SA(0, 1), cA + hstepA, voffA);
        if (wr == 1) PG8_BAR;
        PG8_WAIT_V(4); PG8_BAR;
        PG8_STAGE(PG8_SB(1, 0), cB + kstep, voffB); PG8_STAGE(PG8_SA(1, 0), cA + kstep, voffA); PG8_STAGE(PG8_SB(1, 1), cB + hstepB + kstep, voffB);
        PG8_WAIT_V(6); PG8_BAR;
    }
    for (;;) {
        const bool has_next = S.next(ui + 1, nxt); nxt.idx = ui + 1;
        const char* nA = has_next ? (const char*)g.A + (size_t)nxt.pm * tstepA : cA; const char* nB = has_next ? (const char*)g.Bt + (size_t)nxt.pn * tstepB : cB;
        for (int t = 0; t < nt; t += 2) {
            const bool last = (t == nt - 2);
            const char* a1 = cA + (size_t)(t + 1) * kstep;
            const char* a2 = last ? nA : cA + (size_t)(t + 2) * kstep; const char* b2 = last ? nB : cB + (size_t)(t + 2) * kstep;
            const char* a3 = a2 + kstep; const char* b3 = b2 + kstep;
            if (last && has_next) S.a_ready(nxt);
            if constexpr (SP2 && NB == 1) {
            PG8_LDB(B0, 0, 0); PG8_SCHED; PG8_LDA(At, 0, 0); PG8_STAGE(PG8_SA(1, 1), a1 + hstepA, voffA);
            PG8_WAIT_V(6); PG8_WAIT_L(0); PG8_BAR; PG8_MMA(0, 0, At, B0); PG8_BAR; PG8_SCHED;
            PG8_LDA(At, 0, 1); PG8_STAGE(PG8_SB(0, 0), b2, voffB); PG8_STAGE(PG8_SA(0, 0), a2, voffA);
            PG8_WAIT_V(6); PG8_WAIT_L(0); PG8_BAR; PG8_MMA(1, 0, At, B0); PG8_BAR; PG8_SCHED;
            PG8_LDB(B0, 1, 0); PG8_SCHED; PG8_LDA(At, 1, 0); PG8_STAGE(PG8_SA(0, 1), a2 + hstepA, voffA);
            PG8_WAIT_V(6); PG8_WAIT_L(0); PG8_BAR; PG8_MMA(0, 0, At, B0); PG8_BAR; PG8_SCHED;
            PG8_LDA(At, 1, 1); PG8_STAGE(PG8_SB(1, 0), b3, voffB); PG8_STAGE(PG8_SA(1, 0), a3, voffA);
            PG8_WAIT_V(6); PG8_WAIT_L(0); PG8_BAR; PG8_MMA(1, 0, At, B0); PG8_BAR; PG8_SCHED;
            } else if constexpr (SP2) {
            PG8_LDB(B0, 0, 0); PG8_LDB(B1, 0, 1); PG8_SCHED; PG8_LDA(At, 0, 0); PG8_STAGE(PG8_SA(1, 1), a1 + hstepA, voffA);
            PG8_WAIT_V(8); PG8_WAIT_L(0); PG8_BAR; PG8_MMA(0, 0, At, B0); PG8_MMA(0, 1, At, B1); PG8_BAR; PG8_SCHED;
            PG8_LDA(At, 0, 1); PG8_STAGE(PG8_SB(0, 0), b2, voffB); PG8_STAGE(PG8_SB(0, 1), b2 + hstepB, voffB); PG8_STAGE(PG8_SA(0, 0), a2, voffA);
            PG8_WAIT_V(8); PG8_WAIT_L(0); PG8_BAR; PG8_MMA(1, 0, At, B0); PG8_MMA(1, 1, At, B1); PG8_BAR; PG8_SCHED;
            PG8_LDB(B0, 1, 0); PG8_LDB(B1, 1, 1); PG8_SCHED; PG8_LDA(At, 1, 0); PG8_STAGE(PG8_SA(0, 1), a2 + hstepA, voffA);
            PG8_WAIT_V(8); PG8_WAIT_L(0); PG8_BAR; PG8_MMA(0, 0, At, B0); PG8_MMA(0, 1, At, B1); PG8_BAR; PG8_SCHED;
            PG8_LDA(At, 1, 1); PG8_STAGE(PG8_SB(1, 0), b3, voffB); PG8_STAGE(PG8_SB(1, 1), b3 + hstepB, voffB); PG8_STAGE(PG8_SA(1, 0), a3, voffA);
            PG8_WAIT_V(8); PG8_WAIT_L(0); PG8_BAR; PG8_MMA(1, 0, At, B0); PG8_MMA(1, 1, At, B1); PG8_BAR; PG8_SCHED;
            } else {
            PG8_LDB(B0, 0, 0); PG8_SCHED; PG8_LDA(At, 0, 0); PG8_STAGE(PG8_SA(1, 1), a1 + hstepA, voffA);
            PG8_WAIT_L(8); PG8_BAR; PG8_WAIT_L(0); PG8_MMA(0, 0, At, B0); PG8_BAR; PG8_SCHED;
            PG8_LDB(B1, 0, 1); PG8_STAGE(PG8_SB(0, 0), b2, voffB);
            PG8_BAR; PG8_WAIT_L(0); PG8_MMA(0, 1, At, B1); PG8_BAR;
            PG8_LDA(At, 0, 1); PG8_STAGE(PG8_SA(0, 0), a2, voffA);
            PG8_BAR; PG8_WAIT_L(0); PG8_MMA(1, 0, At, B0); PG8_BAR; PG8_SCHED;
            PG8_STAGE(PG8_SB(0, 1), b2 + hstepB, voffB);
            PG8_WAIT_V(6); PG8_BAR; PG8_MMA(1, 1, At, B1); PG8_BAR;
            PG8_LDB(B0, 1, 0); PG8_SCHED; PG8_LDA(At, 1, 0); PG8_STAGE(PG8_SA(0, 1), a2 + hstepA, voffA);
            PG8_WAIT_L(8); PG8_BAR; PG8_WAIT_L(0); PG8_MMA(0, 0, At, B0); PG8_BAR; PG8_SCHED;
            PG8_LDB(B1, 1, 1); PG8_STAGE(PG8_SB(1, 0), b3, voffB);
            PG8_BAR; PG8_WAIT_L(0); PG8_MMA(0, 1, At, B1); PG8_BAR;
            PG8_LDA(At, 1, 1); PG8_STAGE(PG8_SA(1, 0), a3, voffA);
            PG8_BAR; PG8_WAIT_L(0); PG8_MMA(1, 0, At, B0); PG8_BAR; PG8_SCHED;
            PG8_STAGE(PG8_SB(1, 1), b3 + hstepB, voffB);
            PG8_WAIT_V(6); PG8_BAR; PG8_MMA(1, 1, At, B1); PG8_BAR;
            }
        }
        if constexpr (ALIGN_EPI) { if (wr == 0) PG8_BAR; }
        if constexpr (!Epi::AFTER_DRAIN) { E(acc, cur, wr, wc, fr, fq); S.done(cur); }
        if (!has_next) break;
#pragma unroll
        for (int a = 0; a < 2; ++a)
#pragma unroll
            for (int b = 0; b < 2; ++b)
#pragma unroll
                for (int m = 0; m < 4; ++m)
#pragma unroll
                    for (int n = 0; n < 2; ++n) acc[a][b][m][n] = (f32x4){0.f, 0.f, 0.f, 0.f};
        cur = nxt; cA = nA; cB = nB; ++ui;
        if constexpr (ALIGN_EPI) { if (wr == 1) PG8_BAR; }
    }
    PG8_WAIT_V(0);
    if constexpr (!ALIGN_EPI) { if (wr == 0) PG8_BAR; }
    PG8_BAR;
    if constexpr (Epi::AFTER_DRAIN) { E.fused(acc, cur, wr, wc, fr, fq, lds, wid, lane); S.done(cur); }
#undef PG8_SA
#undef PG8_SB
#undef PG8_STAGE
#undef PG8_LDA
#undef PG8_LDB
#undef PG8_MMA
#undef PG8_WAIT_V
#undef PG8_WAIT_L
#undef PG8_BAR
#undef PG8_SCHED
}
}
#define GAS __attribute__((address_space(1)))
#define LAS __attribute__((address_space(3)))
typedef unsigned short bf16;
typedef long long i64;
typedef unsigned v4u __attribute__((ext_vector_type(4)));
typedef unsigned v2u __attribute__((ext_vector_type(2)));
typedef float f32x4 __attribute__((ext_vector_type(4)));
typedef float f32x16 __attribute__((ext_vector_type(16)));
typedef short bf16x8 __attribute__((ext_vector_type(8)));
typedef short s16x4 __attribute__((ext_vector_type(4)));
typedef GAS unsigned gu32;
#define RLX_AGENT __ATOMIC_RELAXED, __HIP_MEMORY_SCOPE_AGENT
#define LDS_WAIT() asm volatile("s_waitcnt lgkmcnt(0)" ::: "memory")
#define VM_WAIT() asm volatile("s_waitcnt vmcnt(0)" ::: "memory")
typedef float f32x2_t __attribute__((ext_vector_type(2))); typedef __bf16 bf16x2_t __attribute__((ext_vector_type(2)));
__device__ __forceinline__ unsigned pk2(float lo, float hi) { const f32x2_t v = {lo, hi}; const bf16x2_t b = __builtin_convertvector(v, bf16x2_t); return __builtin_bit_cast(unsigned, b); }
__device__ __forceinline__ unsigned f2bf(float f) { return pk2(f, 0.f) & 0xffffu; }
__device__ __forceinline__ float bf2f(unsigned short b) { return __builtin_bit_cast(float, (unsigned)b << 16); }
__device__ __forceinline__ float bflo(unsigned w) { return __builtin_bit_cast(float, w << 16); }
__device__ __forceinline__ float bfhi(unsigned w) { return __builtin_bit_cast(float, w & 0xffff0000u); }
__device__ __forceinline__ float silu_f(float x) { return x * __builtin_amdgcn_rcpf(1.f + __builtin_amdgcn_exp2f(-1.4426950408889634f * x)); }
__device__ __forceinline__ float logsigmoid_f(float x) { return fminf(x, 0.f) - 0.6931471805599453f * __builtin_amdgcn_logf(1.f + __builtin_amdgcn_exp2f(-1.4426950408889634f * fabsf(x))); }
__device__ __forceinline__ float ex2(float x) { return __builtin_amdgcn_exp2f(x); }

constexpr int D = 1024, BATCH = 32, SEQ = 256, DEC_BATCH = 8, DEC_SEQ = 1024, PAST = 512, D_FF = 2816;
constexpr int DEPTH = 4, N_EVEN = 2, N_ODD = 2, GRID_W = 64;
constexpr int UP_FULL_N = 5120;
constexpr int H_A = 4, DK_A = 64, DV_A = 128, GLA_LR = 16;
constexpr int H_B = 4, Q_RANK = 256, KV_RANK = 256, NOPE = 128, ROPE = 64, V_B = 128, QB_W = 768, KV_W = 1024;
constexpr int H_C = 8, DH_C = 64;
constexpr int IN_EVEN = 2144, IN_EVEN_P = 2304, MIXW = 1024, IN_ODD = 3072, PBE_W = 2048, PBO_W = 2048;
constexpr float EPS = 1e-6f;
constexpr int NWAVES = 8, NTHR = 512;
constexpr int M_ALL = 16384, M_CTX = 8192, CROWS = DEC_BATCH * PAST;
constexpr float LOG2E = 1.4426950408889634f;
constexpr float MLA_QSCALE = 0.07216878364870322f * LOG2E;
constexpr float DIFF_QSCALE = 0.125f * LOG2E;
constexpr float LOG2_ROPE_BASE = 13.287712379549449f;

constexpr size_t MiB = 1u << 20;
constexpr size_t WS_CTL = 0;
constexpr int CW_BAR = 4096;
constexpr int CW_PAIR = 16384;
constexpr size_t WS_MODS = 1 * MiB;
constexpr size_t ZERO_BYTES = WS_MODS + (size_t)DEPTH * 9 * 6 * D * 4;
constexpr size_t WS_SHW = 2 * MiB;
constexpr size_t WS_GS = WS_SHW + (size_t)DEPTH * 2 * 9 * 2 * D_FF * 4;
constexpr size_t WS_WINE = 4 * MiB;
constexpr size_t WS_WOUTE = WS_WINE + (size_t)2 * IN_EVEN_P * D * 2;
constexpr size_t WS_WUQ = WS_WOUTE + (size_t)2 * D * MIXW * 2;
constexpr size_t WS_WUKV = WS_WUQ + (size_t)2 * QB_W * Q_RANK * 2;
constexpr size_t WS_WUKVC = WS_WUKV + (size_t)2 * KV_W * KV_RANK * 2;
constexpr size_t WS_WINO = WS_WUKVC + (size_t)2 * KV_W * KV_RANK * 2;
constexpr size_t WS_WOUTO = WS_WINO + (size_t)2 * IN_ODD * D * 2;
constexpr size_t WS_WUP = WS_WOUTO + (size_t)2 * D * MIXW * 2;
constexpr size_t WS_WDN = WS_WUP + (size_t)4 * 2 * D_FF * D * 2;
constexpr size_t WS_CCKV = WS_WDN + (size_t)4 * D * D_FF * 2;
constexpr size_t WS_KNC = WS_CCKV + (size_t)2 * CROWS * KV_RANK * 2;
constexpr size_t WS_VTC = WS_KNC + (size_t)2 * CROWS * 512 * 2;
constexpr size_t WS_KRC = WS_VTC + (size_t)2 * CROWS * 512 * 2;
constexpr size_t WS_KDC = WS_KRC + (size_t)2 * CROWS * 64 * 2;
constexpr size_t WS_VDC = WS_KDC + (size_t)2 * CROWS * 1024 * 2;
constexpr size_t WS_X = WS_VDC + (size_t)2 * CROWS * 1024 * 2;
constexpr size_t WS_XG = WS_X + (size_t)M_ALL * D * 2;
constexpr size_t WS_SSQ = WS_XG + (size_t)M_ALL * D * 2;
constexpr size_t WS_MIX = WS_SSQ + (size_t)2 * M_ALL * 16 * 4;
constexpr size_t WS_SCR = WS_MIX + (size_t)M_ALL * MIXW * 2;
constexpr size_t WS_PBE = WS_SCR;
constexpr size_t WS_QBUF = WS_PBE + (size_t)M_ALL * PBE_W * 2;
constexpr size_t WS_KN = WS_QBUF + (size_t)M_ALL * QB_W * 2;
constexpr size_t WS_VT = WS_KN + (size_t)M_ALL * 512 * 2;
constexpr size_t WS_KR = WS_VT + (size_t)M_ALL * 512 * 2;
constexpr size_t WS_LR = WS_KR + (size_t)M_ALL * 64 * 2;
constexpr size_t WS_SSQC = WS_LR + (size_t)M_ALL * 32 * 4;
constexpr size_t WS_OGB = WS_SSQC + (size_t)2 * M_ALL * 4 * 4;
constexpr size_t WS_LD = WS_OGB + (size_t)M_ALL * 512 * 2;
constexpr size_t WS_EVEN_END = WS_LD + (size_t)M_ALL * 512 * 4;
constexpr size_t WS_PBO = WS_SCR;
constexpr size_t WS_VD = WS_PBO + (size_t)M_ALL * PBO_W * 2;
constexpr size_t WS_OD1 = WS_VD + (size_t)M_ALL * 1024 * 2;
constexpr size_t WS_ODD_END = WS_OD1 + (size_t)M_ALL * 1024 * 2;
constexpr size_t WS_ACT = WS_MIX;
constexpr size_t WS_UB = WS_ACT + (size_t)M_ALL * D_FF * 2;
constexpr size_t WS_FFN_END = WS_UB + (size_t)64 * 8 * 2 * D_FF * 4;
constexpr size_t WS_END = (WS_EVEN_END > WS_ODD_END ? (WS_EVEN_END > WS_FFN_END ? WS_EVEN_END : WS_FFN_END) : (WS_ODD_END > WS_FFN_END ? WS_ODD_END : WS_FFN_END));
static_assert(WS_END <= (size_t)451 * 1000 * 1000, "workspace map exceeds the guaranteed d_ws size");
static_assert(ZERO_BYTES <= WS_SHW && WS_GS + (size_t)DEPTH * 2 * 9 * D * 4 <= WS_WINE, "ws head");

constexpr int RING_BYTES = 131072, LDSCTL_OFF = RING_BYTES, MISC_OFF = LDSCTL_OFF + 320, ARGS_OFF = LDSCTL_OFF + 1024, LDS_BYTES = 147456;
constexpr int RS_OFF = ARGS_OFF + 256, RS_UNITS = 6, SH_OFF = RS_OFF + RS_UNITS * 1024;
static_assert(SH_OFF + RS_UNITS * 1024 <= LDS_BYTES, "LDS map");

__device__ __forceinline__ unsigned long long ldsq(LAS unsigned char* lds, int k) {
    volatile LAS unsigned* p = (volatile LAS unsigned*)(lds + ARGS_OFF) + 2 * k;
    const unsigned lo = (unsigned)__builtin_amdgcn_readfirstlane((int)p[0]), hi = (unsigned)__builtin_amdgcn_readfirstlane((int)p[1]);
    return ((unsigned long long)hi << 32) | lo;
}
#define ARGQ(k) ldsq(lds, (k))
template <class T> __device__ __forceinline__ T* gptr(unsigned long long v) { T* p = (T*)v;
#if defined(__HIP_DEVICE_COMPILE__)
    __builtin_assume(!__builtin_amdgcn_is_shared((const __attribute__((address_space(0))) void*)p)); __builtin_assume(!__builtin_amdgcn_is_private((const __attribute__((address_space(0))) void*)p));
#endif
    return p; }
#define IN_F(k) (gptr<const float>(ARGQ(k)))
#define OUTB (gptr<float>(ARGQ(30)))
#define WSB (gptr<unsigned char>(ARGQ(31)))
#define WSP(T, off) ((T*)(WSB + (off)))
#define x_prompt IN_F(0)
#define x_sample IN_F(1)
#define state_gla IN_F(2)
#define cache_mla_ckv IN_F(3)
#define cache_mla_krope IN_F(4)
#define cache_diff_k IN_F(5)
#define cache_diff_v IN_F(6)
#define cvec IN_F(7)
#define c_ctx IN_F(8)
#define w_ada IN_F(9)
#define b_ada IN_F(10)
#define norm_gain IN_F(11)
#define final_gain IN_F(12)
#define w_in_even IN_F(13)
#define w_out_even IN_F(14)
#define gla_w_decay IN_F(15)
#define gla_b_decay IN_F(16)
#define gla_norm IN_F(17)
#define mla_q_norm IN_F(18)
#define mla_kv_norm IN_F(19)
#define mla_w_uq IN_F(20)
#define mla_w_ukv IN_F(21)
#define w_in_odd IN_F(22)
#define w_out_odd IN_F(23)
#define diff_lambda IN_F(24)
#define diff_norm IN_F(25)
#define ffn_w_up IN_F(26)
#define ffn_conv_w IN_F(27)
#define ffn_conv_b IN_F(28)
#define ffn_w_down IN_F(29)
#define o_y_prompt (OUTB)
#define o_y_sample (OUTB + (i64)BATCH * SEQ * D)
#define o_state (o_y_sample + (i64)DEC_BATCH * DEC_SEQ * D)
#define o_ckv (o_state + (i64)BATCH * N_EVEN * 2 * H_A * DK_A * DV_A)
#define o_krope (o_ckv + (i64)BATCH * N_EVEN * SEQ * KV_RANK)
#define o_dk (o_krope + (i64)BATCH * N_EVEN * SEQ * ROPE)
#define o_dv (o_dk + (i64)BATCH * N_ODD * SEQ * 1024)
#define XB_TMO      128
#define XB_XCNT(j)  (256  + 64 * (j))
#define XB_XSUB(j)  (1280 + 64 * (j))
#define XB_XGEN(j)  (2304 + 64 * (j))
#define XB_TOP      3328
#define XB_TOPGEN   3392
#define XCD_BAR_WORDS 3456
#define XB_SPIN_CAP (1u << 18)

__device__ __forceinline__ unsigned xb_ld(unsigned* p)              { return __hip_atomic_load(p, __ATOMIC_RELAXED, __HIP_MEMORY_SCOPE_AGENT); }
__device__ __forceinline__ unsigned xb_add(unsigned* p, unsigned v) { return __hip_atomic_fetch_add(p, v, __ATOMIC_RELAXED, __HIP_MEMORY_SCOPE_AGENT); }
__device__ __forceinline__ unsigned xb_xcc_id() { return (unsigned)__builtin_amdgcn_s_getreg((3 << 11) | 20) & 0xFu; }
#define XB_SPIN(cond, bar) do { unsigned _sp = 0; while (cond) { __builtin_amdgcn_s_sleep(1); \
    if ((++_sp & 255u) == 0u) { if (xb_ld(&(bar)[XB_TMO])) break; if (_sp > XB_SPIN_CAP) { atomicAdd(&(bar)[XB_TMO], 1u); break; } } } } while (0)

struct XcdBarrier {
    unsigned* bar; unsigned x;
    volatile LAS unsigned* st;
};

__device__ __forceinline__ XcdBarrier xcd_barrier_post(unsigned* bar, volatile LAS unsigned* st) {
    XcdBarrier b; b.bar = bar; b.x = xb_xcc_id(); b.st = st;
    if (threadIdx.x == 0) (void)xb_add(&bar[XB_XCNT(b.x)], 1u);
    return b;
}
__device__ __forceinline__ void xcd_barrier_complete(unsigned* bar, unsigned x, unsigned& nloc, unsigned& nx) {
    const unsigned G = gridDim.x * gridDim.y * gridDim.z;
    unsigned sum, cnt, mine, sp = 0u;
    for (;;) {
        sum = 0u; cnt = 0u; mine = 0u;
#pragma unroll
        for (unsigned j = 0; j < 16; ++j) { const unsigned c = xb_ld(&bar[XB_XCNT(j)]); sum += c; cnt += (c > 0u) ? 1u : 0u; mine = (j == x) ? c : mine; }
        if (sum == G) break;
        __builtin_amdgcn_s_sleep(1);
        if ((++sp & 255u) == 0u) { if (xb_ld(&bar[XB_TMO])) break; if (sp > XB_SPIN_CAP) { atomicAdd(&bar[XB_TMO], 1u); break; } }
    }
    nloc = mine > 0u ? mine : 1u; nx = cnt > 0u ? cnt : 1u;
}

__device__ __forceinline__ void xcd_barrier(const XcdBarrier& b) {
    asm volatile("s_waitcnt vmcnt(0)" ::: "memory");
    __syncthreads();
    if (threadIdx.x == 0) {
        unsigned* bar = b.bar;
        __builtin_amdgcn_s_waitcnt(0);
        unsigned nloc = b.st[0], nx = b.st[1];
        if (nloc == 0u) { xcd_barrier_complete(bar, b.x, nloc, nx); b.st[0] = nloc; b.st[1] = nx; }
        const unsigned old = xb_add(&bar[XB_XSUB(b.x)], 1u);
        const unsigned gen = old / nloc;
        if (old + 1u == (gen + 1u) * nloc) {
            __builtin_amdgcn_fence(__ATOMIC_RELEASE, "agent");
            asm volatile("s_waitcnt vmcnt(0)" ::: "memory");
            const unsigned og = xb_add(&bar[XB_TOP], 1u);
            const unsigned tg = og / nx;
            if (og + 1u == (tg + 1u) * nx) xb_add(&bar[XB_TOPGEN], 1u);
            else XB_SPIN(xb_ld(&bar[XB_TOPGEN]) == tg, bar);
            __builtin_amdgcn_fence(__ATOMIC_ACQUIRE, "agent");
            xb_add(&bar[XB_XGEN(b.x)], 1u);
            asm volatile("s_waitcnt vmcnt(0)" ::: "memory");
        } else {
            XB_SPIN(xb_ld(&bar[XB_XGEN(b.x)]) == gen, bar);
            __builtin_amdgcn_fence(__ATOMIC_ACQUIRE, "agent");
            asm volatile("s_waitcnt vmcnt(0)" ::: "memory");
        }
    }
    __syncthreads();
}
namespace epi {
using pg8::Unit; using pg8::BM; using pg8::HALF;
typedef float f32x4 __attribute__((ext_vector_type(4)));
__device__ __forceinline__ v2u pk4(const f32x4 v) { v2u w; w.x = pk2(v[0], v[1]); w.y = pk2(v[2], v[3]); return w; }
__device__ __forceinline__ float rstd16(const float* p, float inv_n) { const f32x4* q = (const f32x4*)p; const f32x4 a = (q[0] + q[1]) + (q[2] + q[3]); return 1.0f / sqrtf(((a[0] + a[1]) + (a[2] + a[3])) * inv_n + EPS); }
__device__ __forceinline__ float rstd4(const float* p, float inv_n) { const f32x4 a = *(const GAS f32x4*)p; return 1.0f / sqrtf(((a[0] + a[1]) + (a[2] + a[3])) * inv_n + EPS); }
template <int NP> __device__ __forceinline__ void rstd_rows(const float* ssq, int row0  , int fq, float inv_n, float (&out)[2][4]) {
    f32x4 p[2][4];
#pragma unroll
    for (int ai = 0; ai < 2; ++ai)
#pragma unroll
        for (int m = 0; m < 4; ++m) p[ai][m] = *(const GAS f32x4*)(ssq + (unsigned)(row0 + ai * HALF + m * 16) * NP + (NP == 16 ? 4 * fq : 0));
#pragma unroll
    for (int ai = 0; ai < 2; ++ai)
#pragma unroll
        for (int m = 0; m < 4; ++m) { float t = (p[ai][m][0] + p[ai][m][1]) + (p[ai][m][2] + p[ai][m][3]); if (NP == 16) { t += __shfl_xor(t, 16); t += __shfl_xor(t, 32); } out[ai][m] = __builtin_amdgcn_rsqf(t * inv_n + EPS); }
}
template <int NP> __device__ __forceinline__ void rstd_rows8(const float* ssq, int row0, int fq, float inv_n, float (&out)[8]) {
    f32x4 p[8];
#pragma unroll
    for (int k = 0; k < 8; ++k) p[k] = *(const GAS f32x4*)(ssq + (unsigned)(row0 + k) * NP + (NP == 16 ? 4 * fq : 0));
#pragma unroll
    for (int k = 0; k < 8; ++k) { float t = (p[k][0] + p[k][1]) + (p[k][2] + p[k][3]); if (NP == 16) { t += __shfl_xor(t, 16); t += __shfl_xor(t, 32); } out[k] = __builtin_amdgcn_rsqf(t * inv_n + EPS); }
}
__device__ __forceinline__ int mj_of(int pmg);
template <int NP, int NUR = RS_UNITS, class Sched> __device__ __forceinline__ void rstd_prepass(LAS unsigned char* lds, const float* ssq, const Sched& S, float inv_n, const float* shw = nullptr, int pn_off = 0, int slot0 = 0, bool do_sync = true) {
    int tid_ = threadIdx.x; asm volatile("" : "+v"(tid_)); static_assert(NUR <= RS_UNITS, "slots");
    const int r = NP == 16 ? tid_ >> 1 : tid_ & 255, hf = tid_ & 1; f32x4 p[NUR][NP == 16 ? 2 : 1];
#pragma unroll
    for (int i = 0; i < NUR; ++i) { Unit un; un.pm = 0; un.pn = 0; un.idx = 0; const bool ok = S.next(i, un); const GAS float* q = (const GAS float*)ssq + (unsigned)((ok ? un.pm : 0) * BM + r) * NP + (NP == 16 ? 8 * hf : 0);
        p[i][0] = *(const GAS f32x4*)q; if constexpr (NP == 16) p[i][1] = *(const GAS f32x4*)(q + 4); }
    f32x4 shv = {0.f, 0.f, 0.f, 0.f};
    if (shw) { Unit un; un.pm = 0; un.pn = 0; un.idx = 0; const int i = tid_ >> 6; if (i < RS_UNITS && S.next(i, un)) shv = *(const GAS f32x4*)(shw + (unsigned)mj_of(un.pm) * (2 * D_FF) + (un.pn + pn_off) * BM + 4 * (tid_ & 63)); }
#pragma unroll
    for (int i = 0; i < NUR; ++i) { f32x4 a = p[i][0]; if constexpr (NP == 16) a = a + p[i][1]; float t = (a[0] + a[1]) + (a[2] + a[3]); if constexpr (NP == 16) t += __shfl_xor(t, 1);
        if (NP == 16 ? hf == 0 : tid_ < 256) ((LAS float*)(lds + RS_OFF))[(slot0 + i) * 256 + r] = __builtin_amdgcn_rsqf(t * inv_n + EPS); }
    if (shw && (tid_ >> 6) < RS_UNITS) *(LAS f32x4*)(lds + SH_OFF + tid_ * 16) = shv;
    if (do_sync) __syncthreads();
}
__device__ __forceinline__ void vt_store8(bf16* VT, unsigned boff, int T, int t0, int dv, const float (&v)[8]) {
    *(GAS v4u*)(VT + boff + (unsigned)dv * T + t0) = (v4u){pk2(v[0], v[1]), pk2(v[2], v[3]), pk2(v[4], v[5]), pk2(v[6], v[7])};
}
__device__ __forceinline__ int mj_of(int pmg) { return pmg < 32 ? 0 : 1 + ((pmg - 32) >> 2); }
__device__ __forceinline__ int tseq_of(int pmg, int rl) { return pmg < 32 ? rl : ((pmg - 32) & 3) * 256 + rl; }
__device__ __forceinline__ void rope4(f32x4& x1, f32x4& x2, float pos, const f32x4 inv4) {
#pragma unroll
    for (int j = 0; j < 4; ++j) { float rv = pos * inv4[j] * 0.15915494309189535f; rv -= floorf(rv); const float cs = __builtin_amdgcn_cosf(rv), sn = __builtin_amdgcn_sinf(rv);     const float y1 = x1[j] * cs - x2[j] * sn, y2 = x2[j] * cs + x1[j] * sn; x1[j] = y1; x2[j] = y2; }
}
__device__ __forceinline__ f32x4 inv_freq4(int fq) { f32x4 r;
#pragma unroll
    for (int j = 0; j < 4; ++j) r[j] = exp2f(-(float)(2 * (4 * fq + j)) * (LOG2_ROPE_BASE / 32.f)); return r; }
__device__ __forceinline__ void vt_store(bf16* VT, unsigned boff, int T, int t, int dv0, const f32x4 v) {
#pragma unroll
    for (int j = 0; j < 4; ++j) ((GAS bf16*)VT)[boff + (unsigned)(dv0 + j) * T + t] = (bf16)f2bf(v[j]);
}

template <bool MISC> struct EpiInE {
    static constexpr bool PERM = !MISC, AFTER_DRAIN = false, AROWPERM = false;
    LAS unsigned char* lds; int li, l, pn_off;
    __device__ __forceinline__ void operator()(const f32x4 (&acc)[2][2][4][2], const Unit& u, int wr_, int wc_, int fr_, int fq_) const {
        const float* ssq = WSP(float, WS_SSQ); const float* shw = WSP(float, WS_SHW) + (unsigned)(l * 2) * 9 * 2 * D_FF; bf16* PB = WSP(bf16, WS_PBE); float* ssqc = WSP(float, WS_SSQC); float* LR = WSP(float, WS_LR); bf16* KR = WSP(bf16, WS_KR); float* ockv = o_ckv; float* okrope = o_krope;
        int wr = wr_, wc = wc_, fr = fr_, fq = fq_; asm volatile("" : "+s"(wr), "+s"(wc), "+v"(fr), "+v"(fq));
        int rtok = 0;
        const int pm = u.pm, pn = u.pn + pn_off, mj = mj_of(pm);
        const int cq = PERM ? 8 * fq : 4 * fq, cn = PERM ? 4 : 16;
        const LAS float* shp = (const LAS float*)(lds + SH_OFF) + u.idx * 256 + wc * 32 + cq;
        f32x4 sh[2][2];
#pragma unroll
        for (int bj = 0; bj < 2; ++bj)
#pragma unroll
            for (int n = 0; n < 2; ++n) sh[bj][n] = *(const LAS f32x4*)(shp + bj * HALF + n * cn);
        const f32x4 inv4 = inv_freq4(fq);
        float rs[2][4];
#pragma unroll
        for (int ai = 0; ai < 2; ++ai)
#pragma unroll
            for (int m = 0; m < 4; ++m) rs[ai][m] = ((const LAS float*)(lds + RS_OFF))[ai * HALF + wr * 64 + m * 16 + fr];
#pragma unroll
        for (int ai = 0; ai < 2; ++ai)
#pragma unroll
            for (int m = 0; m < 4; ++m) {
                const int rl = ai * HALF + wr * 64 + m * 16 + fr, row = pm * BM + rl;
                const float rstd = rs[ai][m];
                f32x4 v[2][2];
#pragma unroll
                for (int bj = 0; bj < 2; ++bj)
#pragma unroll
                    for (int n = 0; n < 2; ++n) v[bj][n] = acc[ai][bj][m][n] * rstd + sh[bj][n];
                if (pn <= 7) {
                    const float sc = pn == 0 ? 0.125f : 1.f;
                    bf16* dst = PB + (unsigned)row * PBE_W + pn * BM + wc * 32 + cq;
#pragma unroll
                    for (int bj = 0; bj < 2; ++bj) { const v2u a_ = pk4(v[bj][0] * sc), b_ = pk4(v[bj][1] * sc);
                        if constexpr (PERM) *(GAS v4u*)(dst + bj * HALF) = (v4u){a_.x, a_.y, b_.x, b_.y}; else { *(GAS v2u*)(dst + bj * HALF) = a_; *(GAS v2u*)(dst + bj * HALF + 16) = b_; } }
                    if (pn >= 6) {
                        float s = 0.f;
#pragma unroll
                        for (int bj = 0; bj < 2; ++bj)
#pragma unroll
                            for (int n = 0; n < 2; ++n) { const f32x4 q = v[bj][n] * v[bj][n]; s += (q[0] + q[1]) + (q[2] + q[3]); }
                        s += __shfl_xor(s, 16); s += __shfl_xor(s, 32);
                        if (fq == 0) ((GAS float*)ssqc)[((unsigned)(pn - 6) * M_ALL + row) * 4 + wc] = s;
                        if (pn == 7 && pm < 32) { float* o = ockv + ((unsigned)(pm * N_EVEN + li) * SEQ + rl) * KV_RANK + wc * 32 + cq;
#pragma unroll
                            for (int bj = 0; bj < 2; ++bj)
#pragma unroll
                                for (int n = 0; n < 2; ++n) *(GAS f32x4*)(o + bj * HALF + n * cn) = v[bj][n]; }
                    }
                } else if (wc < 2) {
                    f32x4 x1 = v[0][0], x2 = v[0][1];
                    if (pm < 32) { float* o = okrope + ((unsigned)(pm * N_EVEN + li) * SEQ + rl) * ROPE + wc * 32 + 4 * fq; *(GAS f32x4*)o = x1; *(GAS f32x4*)(o + 16) = x2; }
                    else { const int t = tseq_of(pm, rl); rope4(x1, x2, (float)(wc == 0 ? t >> 6 : t & 63), inv4); }
                    bf16* kd = KR + (unsigned)row * ROPE + wc * 32 + 4 * fq; *(GAS v2u*)kd = pk4(x1); *(GAS v2u*)(kd + 16) = pk4(x2);
                } else if (wc == 2) {
                    float* o = LR + (unsigned)row * 32 + 4 * fq; *(GAS f32x4*)o = v[0][0]; *(GAS f32x4*)(o + 16) = v[0][1];
                }
            }
    }
};

struct EpiInO {
    static constexpr bool PERM = false, AFTER_DRAIN = false, AROWPERM = true;
    LAS unsigned char* lds; int li, l;
    __device__ __forceinline__ void operator()(const f32x4 (&acc)[2][2][4][2], const Unit& u, int wr_, int wc_, int fr_, int fq_) const {
        const float* ssq = WSP(float, WS_SSQ); const float* shw = WSP(float, WS_SHW) + (unsigned)(l * 2) * 9 * 2 * D_FF; bf16* PB = WSP(bf16, WS_PBO); bf16* VD = WSP(bf16, WS_VD); float* odk = o_dk; float* odv = o_dv;
        int wr = wr_, wc = wc_, fr = fr_, fq = fq_; asm volatile("" : "+s"(wr), "+s"(wc), "+v"(fr), "+v"(fq));
        const int pm = u.pm, pn = u.pn, mj = mj_of(pm), rl0 = 128 * wr + 8 * fr;
        const LAS float* shp = (const LAS float*)(lds + SH_OFF) + u.idx * 256 + wc * 32 + 4 * fq;
        f32x4 sh[2][2];
#pragma unroll
        for (int bj = 0; bj < 2; ++bj)
#pragma unroll
            for (int n = 0; n < 2; ++n) sh[bj][n] = *(const LAS f32x4*)(shp + bj * HALF + n * 16);
        const f32x4 inv4 = inv_freq4(fq);
        const int Tb = pm < 32 ? SEQ : DEC_SEQ; const unsigned vbase = (unsigned)(pm < 32 ? pm * SEQ : M_CTX + ((pm - 32) >> 2) * DEC_SEQ) * 1024;
        float rs[8]; { const LAS f32x4* rp = (const LAS f32x4*)(lds + RS_OFF + rl0 * 4); const f32x4 r0 = rp[0], r1 = rp[1];     rs[0] = r0[0]; rs[1] = r0[1]; rs[2] = r0[2]; rs[3] = r0[3]; rs[4] = r1[0]; rs[5] = r1[1]; rs[6] = r1[2]; rs[7] = r1[3]; }
        if (pn < 8) { v2u hold[2][2];
#pragma unroll
            for (int k = 0; k < 8; ++k) {
                const int ai = k >> 2, m = k & 3, rl = rl0 + k, row = pm * BM + rl, t = tseq_of(pm, rl);
                f32x4 v[2][2];
#pragma unroll
                for (int bj = 0; bj < 2; ++bj)
#pragma unroll
                    for (int n = 0; n < 2; ++n) v[bj][n] = acc[ai][bj][m][n] * rs[k] + sh[bj][n];
                if (pn >= 4 && pm < 32) { float* o = odk + ((unsigned)(pm * N_ODD + li) * SEQ + rl) * 1024 + (pn - 4) * BM + wc * 32 + 4 * fq;
#pragma unroll
                    for (int bj = 0; bj < 2; ++bj)
#pragma unroll
                        for (int n = 0; n < 2; ++n) *(GAS f32x4*)(o + bj * HALF + n * 16) = v[bj][n]; }
                if (pm >= 32) { const float pos = (float)((wc & 1) == 0 ? t >> 6 : t & 63); rope4(v[0][0], v[0][1], pos, inv4); rope4(v[1][0], v[1][1], pos, inv4); }
                const float sc = pn < 4 ? DIFF_QSCALE : 1.f;
                if ((k & 1) == 0) {
#pragma unroll
                    for (int bj = 0; bj < 2; ++bj)
#pragma unroll
                        for (int n = 0; n < 2; ++n) hold[bj][n] = pk4(v[bj][n] * sc);
                } else { bf16* dst = PB + (unsigned)(row - 1 + (fq & 1)) * PBO_W + pn * BM + wc * 32 + 4 * (fq & ~1);
#pragma unroll
                    for (int bj = 0; bj < 2; ++bj)
#pragma unroll
                        for (int n = 0; n < 2; ++n) { const v2u cur = pk4(v[bj][n] * sc);
                            const auto rx = __builtin_amdgcn_permlane16_swap(hold[bj][n].x, cur.x, false, false), ry = __builtin_amdgcn_permlane16_swap(hold[bj][n].y, cur.y, false, false);
                            *(GAS v4u*)(dst + bj * HALF + n * 16) = (v4u){rx[0], ry[0], rx[1], ry[1]}; } }
                __builtin_amdgcn_sched_barrier(0);
            }
        } else {
            const int t0 = tseq_of(pm, rl0);
#pragma unroll
            for (int bj = 0; bj < 2; ++bj)
#pragma unroll
                for (int n = 0; n < 2; ++n) {
                    if (pm < 32) {
#pragma unroll
                        for (int k = 0; k < 8; ++k) *(GAS f32x4*)(odv + ((unsigned)(pm * N_ODD + li) * SEQ + rl0 + k) * 1024 + (pn - 8) * BM + bj * HALF + wc * 32 + n * 16 + 4 * fq) = acc[k >> 2][bj][k & 3][n] * rs[k] + sh[bj][n]; }
#pragma unroll
                    for (int j = 0; j < 4; ++j) { float c8[8];
#pragma unroll
                        for (int k = 0; k < 8; ++k) c8[k] = acc[k >> 2][bj][k & 3][n][j] * rs[k] + sh[bj][n][j];
                        vt_store8(VD, vbase + (unsigned)((pn - 8) * 2 + bj) * 128 * Tb, Tb, t0, wc * 32 + n * 16 + 4 * fq + j, c8); }
                    __builtin_amdgcn_sched_barrier(0);
                }
        }
    }
};

struct EpiUq {
    static constexpr bool PERM = false, AFTER_DRAIN = false, AROWPERM = false;
    LAS unsigned char* lds;
    __device__ __forceinline__ void operator()(const f32x4 (&acc)[2][2][4][2], const Unit& u, int wr_, int wc_, int fr_, int fq_) const {
        const float* ssqc = WSP(float, WS_SSQC); bf16* QBUF = WSP(bf16, WS_QBUF);
        int wr = wr_, wc = wc_, fr = fr_, fq = fq_; asm volatile("" : "+s"(wr), "+s"(wc), "+v"(fr), "+v"(fq));
        int rtok = 0;
        const int pm = u.pm, pn = u.pn; const f32x4 inv4 = inv_freq4(fq); v2u hold[2][2];
        float rs[2][4];
#pragma unroll
        for (int ai = 0; ai < 2; ++ai)
#pragma unroll
            for (int m = 0; m < 4; ++m) rs[ai][m] = ((const LAS float*)(lds + RS_OFF))[u.idx * 256 + ai * HALF + wr * 64 + m * 16 + fr];
#pragma unroll
        for (int ai = 0; ai < 2; ++ai)
#pragma unroll
            for (int m = 0; m < 4; ++m) {
                const int rl = ai * HALF + wr * 64 + m * 16 + fr, row = pm * BM + rl;
                const float rstd = rs[ai][m] * MLA_QSCALE;
                f32x4 v[2][2];
#pragma unroll
                for (int bj = 0; bj < 2; ++bj)
#pragma unroll
                    for (int n = 0; n < 2; ++n) v[bj][n] = acc[ai][bj][m][n] * rstd;
                if (pn == 2 && pm >= 32) { const int t = tseq_of(pm, rl); const float pos = (float)((wc & 1) == 0 ? t >> 6 : t & 63); rope4(v[0][0], v[0][1], pos, inv4); rope4(v[1][0], v[1][1], pos, inv4); }
                if ((m & 1) == 0) {
#pragma unroll
                    for (int bj = 0; bj < 2; ++bj)
#pragma unroll
                        for (int n = 0; n < 2; ++n) hold[bj][n] = pk4(v[bj][n]);
                } else { bf16* dst = QBUF + (unsigned)(row - 16 + 16 * (fq & 1)) * QB_W + pn * BM + wc * 32 + 4 * (fq & ~1);
#pragma unroll
                    for (int bj = 0; bj < 2; ++bj)
#pragma unroll
                        for (int n = 0; n < 2; ++n) { const v2u cur = pk4(v[bj][n]);
                            const auto rx = __builtin_amdgcn_permlane16_swap(hold[bj][n].x, cur.x, false, false), ry = __builtin_amdgcn_permlane16_swap(hold[bj][n].y, cur.y, false, false);
                            *(GAS v4u*)(dst + bj * HALF + n * 16) = (v4u){rx[0], ry[0], rx[1], ry[1]}; } }
            }
    }
};

template <int MODE> struct EpiKV {
    static constexpr bool PERM = true, AFTER_DRAIN = false, AROWPERM = true;
    LAS unsigned char* lds; int li;
    __device__ __forceinline__ void operator()(const f32x4 (&acc)[2][2][4][2], const Unit& u, int wr_, int wc_, int fr_, int fq_) const {
        const float* ssqc = WSP(float, WS_SSQC) + (unsigned)M_ALL * 4; bf16* KN = MODE == 1 ? WSP(bf16, WS_KNC) + (unsigned)li * CROWS * 512 : WSP(bf16, WS_KN); bf16* VT = MODE == 1 ? WSP(bf16, WS_VTC) + (unsigned)li * CROWS * 512 : WSP(bf16, WS_VT);
        int wr = wr_, wc = wc_, fr = fr_, fq = fq_; asm volatile("" : "+s"(wr), "+s"(wc), "+v"(fr), "+v"(fq));
        const int pm = u.pm, pn = u.pn, rl0 = 128 * wr + 8 * fr;
        const int Tb = MODE == 1 ? PAST : (pm < 32 ? SEQ : DEC_SEQ);
        const unsigned vbase = (unsigned)(MODE == 1 ? (pm >> 1) * PAST : (pm < 32 ? pm * SEQ : M_CTX + ((pm - 32) >> 2) * DEC_SEQ)) * 512;
        float rs[8];
        if (MODE == 0) { const LAS f32x4* rp = (const LAS f32x4*)(lds + RS_OFF + ((u.idx + 2) * 256 + rl0) * 4);     const f32x4 r0 = rp[0], r1 = rp[1]; rs[0] = r0[0]; rs[1] = r0[1]; rs[2] = r0[2]; rs[3] = r0[3]; rs[4] = r1[0]; rs[5] = r1[1]; rs[6] = r1[2]; rs[7] = r1[3]; }
        else {
#pragma unroll
            for (int k = 0; k < 8; ++k) rs[k] = 1.f; }
        if (pn < 2) {
#pragma unroll
            for (int k = 0; k < 8; ++k) { bf16* dst = KN + (unsigned)(pm * BM + rl0 + k) * 512 + pn * BM + wc * 32 + 8 * fq;
#pragma unroll
                for (int bj = 0; bj < 2; ++bj) { const v2u a_ = pk4(acc[k >> 2][bj][k & 3][0] * rs[k]), b_ = pk4(acc[k >> 2][bj][k & 3][1] * rs[k]); *(GAS v4u*)(dst + bj * HALF) = (v4u){a_.x, a_.y, b_.x, b_.y}; } }
        } else {
            const int t0 = MODE == 1 ? (pm & 1) * 256 + rl0 : tseq_of(pm, rl0);
#pragma unroll
            for (int bj = 0; bj < 2; ++bj)
#pragma unroll
                for (int n = 0; n < 2; ++n)
#pragma unroll
                    for (int j = 0; j < 4; ++j) { float c8[8];
#pragma unroll
                        for (int k = 0; k < 8; ++k) c8[k] = acc[k >> 2][bj][k & 3][n][j] * rs[k];
                        vt_store8(VT, vbase + (unsigned)((pn - 2) * 2 + bj) * 128 * Tb, Tb, t0, wc * 32 + 8 * fq + 4 * n + j, c8); }
        }
    }
};

template <bool IN32> struct EpiOut {
    static constexpr bool PERM = true, AFTER_DRAIN = false, AROWPERM = false;
    LAS unsigned char* lds; int l, down, half;
    __device__ __forceinline__ void operator()(const f32x4 (&acc)[2][2][4][2], const Unit& u, int wr_, int wc_, int fr_, int fq_) const {
        bf16* X = WSP(bf16, WS_X); bf16* XG = WSP(bf16, WS_XG); const float* modl = WSP(float, WS_MODS) + (unsigned)l * 9 * 6 * D; const int ln = l + 1 < DEPTH ? l + 1 : l;
        const float* xp = x_prompt; const float* xs = x_sample;
        float* ssq_out = WSP(float, WS_SSQ) + (down ? 0u : (unsigned)M_ALL * 16); const float* gate = modl + (down ? 5 : 2) * D;
        const int pm_off = down ? half * 32 : 0, write_xg = down ? (l + 1 < DEPTH) : 1;
        int wr = wr_, wc = wc_, fr = fr_, fq = fq_; asm volatile("" : "+s"(wr), "+s"(wc), "+v"(fr), "+v"(fq));
        const int pmg = u.pm + pm_off, pn = u.pn, mj = mj_of(pmg), c0 = pn * BM + wc * 32 + 8 * fq;
        const float* gsp = WSP(float, WS_GS) + (unsigned)((l * 2 + down) * 9 + mj) * D;
        const float* xo = (pmg < 32 ? xp + (unsigned)pmg * BM * D : xs + (unsigned)(pmg - 32) * BM * D) + c0; const bf16* xo16 = X + (unsigned)pmg * BM * D + c0;
        constexpr int DP = IN32 ? 3 : 6;
        f32x4 xb[IN32 ? DP : 1][2][2]; v4u xr[IN32 ? 1 : DP][2];
        int tok = 0;
#define EO_LOAD(buf, q) do { const int rl_ = ((q) >> 2) * HALF + wr * 64 + ((q) & 3) * 16 + fr + tok; \
            _Pragma("unroll") for (int bj = 0; bj < 2; ++bj) { if constexpr (IN32) { xb[buf][bj][0] = *(const GAS f32x4*)(xo + (unsigned)rl_ * D + bj * HALF); xb[buf][bj][1] = *(const GAS f32x4*)(xo + (unsigned)rl_ * D + bj * HALF + 4); } \
                else xr[buf][bj] = *(const GAS v4u*)(xo16 + (unsigned)rl_ * D + bj * HALF); } } while (0)
#define EO_PROC(buf, q) do { const int ai_ = (q) >> 2, m_ = (q) & 3, rl_ = ai_ * HALF + wr * 64 + m_ * 16 + fr; const unsigned row = (unsigned)pmg * BM + rl_; float s = 0.f; \
            _Pragma("unroll") for (int bj = 0; bj < 2; ++bj) { f32x4 r0_, r1_; if constexpr (IN32) { r0_ = xb[buf][bj][0]; r1_ = xb[buf][bj][1]; } \
                else { const v4u w_ = xr[buf][bj]; r0_ = (f32x4){bflo(w_.x), bfhi(w_.x), bflo(w_.y), bfhi(w_.y)}; r1_ = (f32x4){bflo(w_.z), bfhi(w_.z), bflo(w_.w), bfhi(w_.w)}; } \
                const f32x4 x0 = r0_ + gt[bj][0] * acc[ai_][bj][m_][0], x1 = r1_ + gt[bj][1] * acc[ai_][bj][m_][1]; \
                { const v2u a_ = pk4(x0), b_ = pk4(x1); *(GAS v4u*)(X + row * D + c0 + bj * HALF) = (v4u){a_.x, a_.y, b_.x, b_.y}; } \
                const f32x4 q4 = x0 * x0 + x1 * x1; s += (q4[0] + q4[1]) + (q4[2] + q4[3]); \
                if (write_xg) { const v2u a_ = pk4(x0 * gs[bj][0]), b_ = pk4(x1 * gs[bj][1]); *(GAS v4u*)(XG + row * D + c0 + bj * HALF) = (v4u){a_.x, a_.y, b_.x, b_.y}; } } \
            s += __shfl_xor(s, 16); s += __shfl_xor(s, 32); asm volatile("" : "+v"(tok), "+v"(s)); \
            if (fq == 0) ((GAS float*)ssq_out)[row * 16 + pn * 4 + wc] = s; } while (0)
#pragma unroll
        for (int q = 0; q < DP; ++q) EO_LOAD(q % DP, q);
        f32x4 gt[2][2], gs[2][2];
#pragma unroll
        for (int bj = 0; bj < 2; ++bj)
#pragma unroll
            for (int n = 0; n < 2; ++n) { gt[bj][n] = *(const GAS f32x4*)(gate + (unsigned)mj * 6 * D + c0 + bj * HALF + n * 4);
                gs[bj][n] = *(const GAS f32x4*)(gsp + c0 + bj * HALF + n * 4); }
#pragma unroll
        for (int q = 0; q < 8; ++q) { EO_PROC(q % DP, q); if (q + DP < 8) EO_LOAD(q % DP, q + DP); }
#undef EO_LOAD
#undef EO_PROC
    }
};

__device__ __forceinline__ f32x4 dpp_shr1(const f32x4 v) { f32x4 r; const int ln = __lane_id();
#pragma unroll
    for (int j = 0; j < 4; ++j) { const float t = __shfl(v[j], (ln - 1) & 63); r[j] = (ln & 15) == 0 ? 0.f : t; } return r; }
__device__ __forceinline__ f32x4 dpp_shl1(const f32x4 v) { f32x4 r; const int ln = __lane_id();
#pragma unroll
    for (int j = 0; j < 4; ++j) { const float t = __shfl(v[j], (ln + 1) & 63); r[j] = (ln & 15) == 15 ? 0.f : t; } return r; }
#ifndef UC_AT
#define UC_AT 4
#endif
template <bool TAIL> struct EpiUpConv {
    static constexpr bool PERM = TAIL, AFTER_DRAIN = false, AROWPERM = true;
    LAS unsigned char* lds; int l;
    __device__ __forceinline__ void operator()(const f32x4 (&acc)[2][2][4][2], const Unit& u, int wr_, int wc_, int fr_, int fq_) const {
        int wr = wr_, wc = wc_, fr = fr_, fq = fq_; asm volatile("" : "+s"(wr), "+s"(wc), "+v"(fr), "+v"(fq));
        const int pm = u.pm, pn = u.pn, mj = mj_of(pm), t0 = 128 * wr + 8 * fr;
        const float* ssq = WSP(float, WS_SSQ) + (unsigned)M_ALL * 16; const float* shw = WSP(float, WS_SHW) + (unsigned)(l * 2 + 1) * 9 * 2 * D_FF + (unsigned)mj * 2 * D_FF + (TAIL ? UP_FULL_N + pn * HALF : pn * BM);
        const float* cw = ffn_conv_w + (unsigned)l * 3 * 2 * D_FF; const float* cb = ffn_conv_b + (unsigned)l * 2 * D_FF; bf16* ACT = WSP(bf16, WS_ACT); float* UB = WSP(float, WS_UB) + (unsigned)pm * 8 * 2 * D_FF;
        f32x4 C[TAIL ? 1 : 2][10]; int ctok = 0;
#define UC_LOAD(n_) do { const int cl_ = (TAIL ? wc * 32 + 8 * fq : wc * 32 + 16 * (n_) + 4 * fq) + ctok, fa_ = TAIL ? UP_FULL_N / 2 + pn * 64 + 16 * wc + 4 * fq + ctok : pn * HALF + cl_; \
            C[n_][0] = *(const GAS f32x4*)(shw + cl_); C[n_][1] = *(const GAS f32x4*)(shw + (TAIL ? 4 : HALF) + cl_); \
            _Pragma("unroll") for (int d = 0; d < 3; ++d) { C[n_][2 + d] = *(const GAS f32x4*)(cw + d * 2 * D_FF + fa_); C[n_][5 + d] = *(const GAS f32x4*)(cw + d * 2 * D_FF + D_FF + fa_); } \
            C[n_][8] = *(const GAS f32x4*)(cb + fa_); C[n_][9] = *(const GAS f32x4*)(cb + D_FF + fa_); } while (0)
        float rs[8];
        UC_LOAD(0);
        { const LAS f32x4* rp = (const LAS f32x4*)(lds + RS_OFF + t0 * 4); const f32x4 r0 = rp[0], r1 = rp[1];     rs[0] = r0[0]; rs[1] = r0[1]; rs[2] = r0[2]; rs[3] = r0[3]; rs[4] = r1[0]; rs[5] = r1[1]; rs[6] = r1[2]; rs[7] = r1[3]; }
#pragma unroll
        for (int n = 0; n < (TAIL ? 1 : 2); ++n) {
            const int cl = TAIL ? wc * 32 + 8 * fq : wc * 32 + 16 * n + 4 * fq, fa = TAIL ? UP_FULL_N / 2 + pn * 64 + 16 * wc + 4 * fq : pn * HALF + cl;
            const f32x4 sha = C[n][0], shg = C[n][1], ba = C[n][8], bg = C[n][9];
            f32x4 wa[3], wg[3];
#pragma unroll
            for (int d = 0; d < 3; ++d) { wa[d] = C[n][2 + d]; wg[d] = C[n][5 + d]; }
#define UA(k) (acc[(k) >> 2][0][(k) & 3][n] * rs[k] + sha)
#define UG(k) (acc[(k) >> 2][TAIL ? 0 : 1][(k) & 3][TAIL ? 1 : n] * rs[k] + shg)
            v2u hold = {0u, 0u};
            f32x4 a0 = dpp_shr1(UA(7)), g0 = dpp_shr1(UG(7));
            f32x4 a1 = UA(0), g1 = UG(0);
            const f32x4 anx = dpp_shl1(a1), gnx = dpp_shl1(g1);
#pragma unroll
            for (int k = 0; k < 8; ++k) {
                f32x4 a2, g2; if (k < 7) { a2 = UA(k < 7 ? k + 1 : 7); g2 = UG(k < 7 ? k + 1 : 7); } else { a2 = anx; g2 = gnx; }
                const f32x4 ca = ba + wa[0] * a0 + wa[1] * a1 + wa[2] * a2, cg = bg + wg[0] * g0 + wg[1] * g1 + wg[2] * g2;
                const unsigned row = (unsigned)(pm * BM + t0 + k);
                const v2u res = (v2u){pk2(silu_f(ca[0]) * cg[0], silu_f(ca[1]) * cg[1]), pk2(silu_f(ca[2]) * cg[2], silu_f(ca[3]) * cg[3])};
                if ((k & 1) == 0) hold = res;
                else { const auto rx = __builtin_amdgcn_permlane16_swap(hold.x, res.x, false, false), ry = __builtin_amdgcn_permlane16_swap(hold.y, res.y, false, false);
                    const int kk = k - 1 + (fq & 1);
                    if (!((kk == 0 && fr == 0) || (kk == 7 && fr == 15))) *(GAS v4u*)(ACT + (row - 1 + (fq & 1)) * D_FF + fa - 4 * (fq & 1)) = (v4u){rx[0], ry[0], rx[1], ry[1]}; }
                if ((k < 2 && fr == 0) || (k >= 6 && fr == 15)) { float* ub = UB + (unsigned)(wr * 4 + (k < 2 ? k : k - 4)) * 2 * D_FF + fa; *(GAS f32x4*)ub = a1; *(GAS f32x4*)(ub + D_FF) = g1; }
                a0 = a1; g0 = g1; a1 = a2; g1 = g2;
                if constexpr (!TAIL) { if (n == 0 && k == UC_AT) { asm volatile("" : "+v"(ctok), "+v"(a1)); UC_LOAD(1); } }
            }
#undef UA
#undef UG
        }
#undef UC_LOAD
    }
};
}
#ifndef REP_QK
#define REP_QK 1
#endif
namespace attn {
struct KSrc { const bf16* k1; const bf16* k2; const bf16* vt; int ld1, ld2, ldv, pad_; };
template <int DQ> struct Geo { static constexpr int KROW = (DQ + 8) * 2, KTILE = 64 * KROW, VROW = 144, VTILE = 128 * VROW, NKC = DQ / 64; };
__device__ __forceinline__ f32x16 mfma32(bf16x8 a, bf16x8 b, f32x16 c) { return __builtin_amdgcn_mfma_f32_32x32x16_bf16(a, b, c, 0, 0, 0); }

__device__ __forceinline__ KSrc ksel(bool c, const KSrc& a, const KSrc& b) { KSrc r; r.k1 = c ? a.k1 : b.k1; r.k2 = c ? a.k2 : b.k2; r.vt = c ? a.vt : b.vt; r.ld1 = c ? a.ld1 : b.ld1; r.ld2 = c ? a.ld2 : b.ld2; r.ldv = c ? a.ldv : b.ldv; r.pad_ = 0; return r; }
template <int DQ> __device__ __forceinline__ void load_k(const KSrc s, int key0, int tid, v4u (&kr)[Geo<DQ>::NKC]) {
    constexpr int CPR = DQ / 8;
#pragma unroll
    for (int i = 0; i < Geo<DQ>::NKC; ++i) { const int c = tid + NTHR * i, row = c / CPR, ch = c % CPR;
        const bf16* src = (DQ == 192 && ch >= 16) ? s.k2 + (unsigned)((key0 + row) * s.ld2 + (ch - 16) * 8) : s.k1 + (unsigned)((key0 + row) * s.ld1 + ch * 8);
        kr[i] = *(const GAS v4u*)src; }
}
__device__ __forceinline__ void load_v(const KSrc s, int key0, int tid, v4u (&vr)[2]) {
#pragma unroll
    for (int i = 0; i < 2; ++i) { const int c = tid + NTHR * i, dvr = c >> 3, ch = c & 7; vr[i] = *(const GAS v4u*)(s.vt + (unsigned)(dvr * s.ldv + key0 + ch * 8)); }
}
template <int DQ> __device__ __forceinline__ void store_k(LAS unsigned char* kb, int tid, const v4u (&kr)[Geo<DQ>::NKC]) {
    constexpr int CPR = DQ / 8;
#pragma unroll
    for (int i = 0; i < Geo<DQ>::NKC; ++i) { const int c = tid + NTHR * i, row = c / CPR, ch = c % CPR; *(LAS v4u*)(kb + row * Geo<DQ>::KROW + ch * 16) = kr[i]; }
}
template <int DQ> __device__ __forceinline__ void store_v(LAS unsigned char* vb, int tid, const v4u (&vr)[2]) {
#pragma unroll
    for (int i = 0; i < 2; ++i) { const int c = tid + NTHR * i, dvr = c >> 3, ch = c & 7, s = ch >> 1, b = ch & 1; LAS unsigned char* d = vb + dvr * Geo<DQ>::VROW + (16 * s + 4 * b) * 2;
        *(LAS v2u*)d = (v2u){vr[i].x, vr[i].y}; *(LAS v2u*)(d + 16) = (v2u){vr[i].z, vr[i].w}; }
}

#define ATT_DSR(dst, addr, off) asm volatile("ds_read_b128 %0, %1 offset:%2" : "=v"(dst) : "v"(addr), "n"(off))
#define ATT_WAIT(n) do { asm volatile("s_waitcnt lgkmcnt(" #n ")" ::: "memory"); __builtin_amdgcn_sched_barrier(0); } while (0)
template <int DQ, bool COMB = false, bool PP = (DQ == 64)> __device__ __forceinline__ void attn_unit(LAS unsigned char* lds, const bf16* Q, const bf16* Q2, int ldq, const KSrc cs, int nct, const KSrc ns, int nnt, bf16* O, int ldo, float lam = 0.f, float oscale = 1.f, const float* gain = nullptr) {
    typedef Geo<DQ> G;
    int tid_ = threadIdx.x; asm volatile("" : "+v"(tid_));
    const int tid = tid_, lane = tid & 63, w = tid >> 6, n = lane & 31, hh = lane >> 5, grp = __builtin_amdgcn_readfirstlane(tid >> 8);
    constexpr int NS = DQ / 16, NS1 = DQ == 192 ? 8 : 4, STAGE = G::KTILE + G::VTILE;
    static_assert(2 * STAGE <= RING_BYTES, "attention LDS map");
    bf16x8 qf[NS];
    { const bf16* qr = Q + (unsigned)((32 * w + n) * ldq + 8 * hh);
#pragma unroll
      for (int i = 0; i < NS1; ++i) qf[i] = *(const GAS bf16x8*)(qr + 16 * i);
      if (DQ == 192) { const bf16* qr2 = Q2 + (unsigned)((32 * w + n) * ldq + 8 * hh);
#pragma unroll
          for (int i = NS1; i < NS; ++i) qf[i] = *(const GAS bf16x8*)(qr2 + 16 * (i - NS1)); } }
    f32x16 o[4];
#pragma unroll
    for (int d = 0; d < 4; ++d)
#pragma unroll
        for (int r = 0; r < 16; ++r) o[d][r] = 0.f;
    float mrun = -1e30f, lrun = 0.f;
    const int NT = nct + nnt;
    constexpr int AHEAD = DQ == 64 ? 2 : 1;
    v4u krA[G::NKC], vrA[2], krB[AHEAD == 2 ? G::NKC : 1], vrB[AHEAD == 2 ? 2 : 1];
#define ATT_SRC(t) ksel((t) < nct, cs, ns)
#define ATT_KEY0(t) (64 * ((t) < nct ? (t) : (t) - nct))
    load_k<DQ>(ATT_SRC(0), ATT_KEY0(0), tid, krA); load_v(ATT_SRC(0), ATT_KEY0(0), tid, vrA);
    store_k<DQ>(lds, tid, krA); store_v<DQ>(lds + G::KTILE, tid, vrA);
#pragma unroll
    for (int i = 0; i < NS; ++i) asm volatile("" :: "v"(qf[i]));
    if constexpr (AHEAD == 2) { load_k<DQ>(ATT_SRC(1), ATT_KEY0(1), tid, krB); load_v(ATT_SRC(1), ATT_KEY0(1), tid, vrB); }
    __syncthreads();
    const unsigned lds0 = (unsigned)(size_t)lds;
    auto iter = [&](const int tt, auto& kx, auto& vx, auto& ky, auto& vy) __attribute__((always_inline)) {
        const unsigned ka = lds0 + (tt & 1) * STAGE + n * G::KROW + 16 * hh, va = lds0 + (tt & 1) * STAGE + G::KTILE + n * G::VROW + 16 * hh;
        { const int tl = tt + AHEAD < NT ? tt + AHEAD : NT - 1;
          load_k<DQ>(ATT_SRC(tl), ATT_KEY0(tl), tid, kx); load_v(ATT_SRC(tl), ATT_KEY0(tl), tid, vx); }
        asm volatile("s_waitcnt lgkmcnt(0)" ::: "memory");
        f32x16 p0, p1;
        for (int rq_ = 0; rq_ < REP_QK; ++rq_) {
#pragma unroll
        for (int r = 0; r < 16; ++r) { p0[r] = 0.f; p1[r] = 0.f; }
        { v4u kf[3][2];
          ATT_DSR(kf[0][0], ka, 0); ATT_DSR(kf[0][1], ka, 32 * G::KROW);
          ATT_DSR(kf[1][0], ka, 32); ATT_DSR(kf[1][1], ka, 32 * G::KROW + 32);
          __builtin_amdgcn_s_setprio(1);
#pragma unroll
          for (int i = 0; i < NS; ++i) {
              if (i + 2 < NS) { ATT_DSR(kf[(i + 2) % 3][0], ka, 32 * (i + 2)); ATT_DSR(kf[(i + 2) % 3][1], ka, 32 * G::KROW + 32 * (i + 2)); }
              if (i + 2 < NS) ATT_WAIT(4); else if (i + 1 < NS) ATT_WAIT(2); else ATT_WAIT(0);
              p0 = mfma32(__builtin_bit_cast(bf16x8, kf[i % 3][0]), qf[i], p0); p1 = mfma32(__builtin_bit_cast(bf16x8, kf[i % 3][1]), qf[i], p1); }
          __builtin_amdgcn_s_setprio(0); }
        asm volatile("" : "+v"(p0), "+v"(p1)); }
        v4u vf[2][4];
        if constexpr (!PP) {
#pragma unroll
            for (int d = 0; d < 4; ++d) ATT_DSR(vf[0][d], va, d * 32 * G::VROW);
#pragma unroll
            for (int d = 0; d < 4; ++d) ATT_DSR(vf[1][d], va, d * 32 * G::VROW + 32); }
        float mx;
        asm("v_max3_f32 %0, %1, %2, %3" : "=v"(mx) : "v"(p0[0]), "v"(p1[0]), "v"(p0[1]));
#pragma unroll
        for (int r = 1; r < 15; ++r) asm("v_max3_f32 %0, %1, %2, %3" : "=v"(mx) : "v"(mx), "v"(p1[r]), "v"(p0[r + 1]));
        asm("v_max3_f32 %0, %1, %2, %3" : "=v"(mx) : "v"(mx), "v"(p1[15]), "v"(p1[15]));
        const float mxo = __shfl_xor(mx, 32);
        if constexpr (PP) {
            if (grp == 1 && tt + 1 < NT) { store_k<DQ>(lds + ((tt + 1) & 1) * STAGE, tid, ky); store_v<DQ>(lds + ((tt + 1) & 1) * STAGE + G::KTILE, tid, vy); }
            __syncthreads();
#pragma unroll
            for (int d = 0; d < 4; ++d) ATT_DSR(vf[0][d], va, d * 32 * G::VROW);
#pragma unroll
            for (int d = 0; d < 4; ++d) ATT_DSR(vf[1][d], va, d * 32 * G::VROW + 32); }
        asm("v_max_f32 %0, %1, %2" : "=v"(mx) : "v"(mx), "v"(mxo));
        if (__builtin_amdgcn_ballot_w64(mx > mrun + 8.f) != 0) { const float mnew = fmaxf(mrun, mx), alpha = ex2(mrun - mnew); mrun = mnew; lrun *= alpha;
#pragma unroll
            for (int d = 0; d < 4; ++d)
#pragma unroll
                for (int r = 0; r < 16; ++r) o[d][r] *= alpha; }
        const f32x2_t mref2 = {mrun, mrun}; f32x2_t ls2 = {0.f, 0.f};
        auto exps = [&](const int s, const int part) __attribute__((always_inline)) { const int r = 8 * (s & 1) + 2 * part;
            if (s >> 1) { f32x2_t t = (f32x2_t){p1[r], p1[r + 1]} - mref2; t[0] = ex2(t[0]); t[1] = ex2(t[1]); ls2 += t; p1[r] = t[0]; p1[r + 1] = t[1]; }
            else { f32x2_t t = (f32x2_t){p0[r], p0[r + 1]} - mref2; t[0] = ex2(t[0]); t[1] = ex2(t[1]); ls2 += t; p0[r] = t[0]; p0[r + 1] = t[1]; } };
#pragma unroll
        for (int part = 0; part < 4; ++part) exps(0, part);
#pragma unroll
        for (int s = 0; s < 4; ++s) { v4u pw;
#pragma unroll
            for (int j = 0; j < 4; ++j) { const int r = 8 * (s & 1) + 2 * j; pw[j] = (s >> 1) ? pk2(p1[r], p1[r + 1]) : pk2(p0[r], p0[r + 1]); }
            const bf16x8 pf = __builtin_bit_cast(bf16x8, pw);
            if (s == 0) ATT_WAIT(4); else if (s == 1) ATT_WAIT(4); else if (s == 2) ATT_WAIT(4); else ATT_WAIT(0);
            if (s == 3) __builtin_amdgcn_s_setprio(1);
#pragma unroll
            for (int d = 0; d < 4; ++d) { o[d] = mfma32(__builtin_bit_cast(bf16x8, vf[s & 1][d]), pf, o[d]); if (s < 3) exps(s + 1, d); __builtin_amdgcn_sched_barrier(0); }
            if (s == 3) __builtin_amdgcn_s_setprio(0);
            if (s + 2 < 4) {
#pragma unroll
                for (int d = 0; d < 4; ++d) ATT_DSR(vf[s & 1][d], va, d * 32 * G::VROW + 32 * (s + 2)); } }
        lrun += ls2[0] + ls2[1];
        __builtin_amdgcn_sched_barrier(0);
        if ((!PP || grp == 0) && tt + 1 < NT) { store_k<DQ>(lds + ((tt + 1) & 1) * STAGE, tid, ky); store_v<DQ>(lds + ((tt + 1) & 1) * STAGE + G::KTILE, tid, vy); }
        __syncthreads();
    };
    if constexpr (PP) { if (grp == 1) __builtin_amdgcn_s_barrier(); }
    if constexpr (AHEAD == 2) { for (int tt = 0; tt < NT; tt += 2) { iter(tt, krA, vrA, krB, vrB); iter(tt + 1, krB, vrB, krA, vrA); } }
    else { for (int tt = 0; tt < NT; ++tt) iter(tt, krA, vrA, krA, vrA); }
    if constexpr (PP) { if (grp == 0) __builtin_amdgcn_s_barrier(); }
#undef ATT_SRC
#undef ATT_KEY0
    const float inv = 1.0f / (lrun + __shfl_xor(lrun, 32));
    bf16* orow = O + (unsigned)((32 * w + n) * ldo + 4 * hh);
    if constexpr (COMB) {
        asm volatile("s_waitcnt vmcnt(0)" ::: "memory");
        float ss = 0.f;
#pragma unroll
        for (int d = 0; d < 4; ++d)
#pragma unroll
            for (int r4 = 0; r4 < 4; ++r4) { const v2u w0 = *(const GAS v2u*)(orow + 32 * d + 8 * r4);
                o[d][4 * r4] = bflo(w0.x) - lam * (o[d][4 * r4] * inv); o[d][4 * r4 + 1] = bfhi(w0.x) - lam * (o[d][4 * r4 + 1] * inv); o[d][4 * r4 + 2] = bflo(w0.y) - lam * (o[d][4 * r4 + 2] * inv); o[d][4 * r4 + 3] = bfhi(w0.y) - lam * (o[d][4 * r4 + 3] * inv);
                ss += (o[d][4 * r4] * o[d][4 * r4] + o[d][4 * r4 + 1] * o[d][4 * r4 + 1]) + (o[d][4 * r4 + 2] * o[d][4 * r4 + 2] + o[d][4 * r4 + 3] * o[d][4 * r4 + 3]); }
        ss += __shfl_xor(ss, 32);
        const float rs = oscale / sqrtf(ss * (1.f / 128.f) + EPS);
#pragma unroll
        for (int d = 0; d < 4; ++d)
#pragma unroll
            for (int r4 = 0; r4 < 4; r4 += 2) { const f32x4 g4 = *(const GAS f32x4*)(gain + 32 * d + 8 * r4 + 4 * hh), h4 = *(const GAS f32x4*)(gain + 32 * d + 8 * r4 + 8 + 4 * hh);
                v2u wa, wb; wa.x = pk2(o[d][4 * r4] * rs * g4[0], o[d][4 * r4 + 1] * rs * g4[1]); wa.y = pk2(o[d][4 * r4 + 2] * rs * g4[2], o[d][4 * r4 + 3] * rs * g4[3]);
                wb.x = pk2(o[d][4 * r4 + 4] * rs * h4[0], o[d][4 * r4 + 5] * rs * h4[1]); wb.y = pk2(o[d][4 * r4 + 6] * rs * h4[2], o[d][4 * r4 + 7] * rs * h4[3]);
                const auto rx = __builtin_amdgcn_permlane32_swap(wa.x, wb.x, false, false), ry = __builtin_amdgcn_permlane32_swap(wa.y, wb.y, false, false);
                *(GAS v4u*)(O + (unsigned)((32 * w + n) * ldo + 8 * hh) + 32 * d + 8 * r4) = (v4u){rx[0], ry[0], rx[1], ry[1]}; }
    } else {
    bf16* orow16 = O + (unsigned)((32 * w + n) * ldo + 8 * hh);
#pragma unroll
    for (int d = 0; d < 4; ++d)
#pragma unroll
        for (int r4 = 0; r4 < 4; r4 += 2) { v2u wa, wb; wa.x = pk2(o[d][4 * r4] * inv, o[d][4 * r4 + 1] * inv); wa.y = pk2(o[d][4 * r4 + 2] * inv, o[d][4 * r4 + 3] * inv);
            wb.x = pk2(o[d][4 * r4 + 4] * inv, o[d][4 * r4 + 5] * inv); wb.y = pk2(o[d][4 * r4 + 6] * inv, o[d][4 * r4 + 7] * inv);
            const auto rx = __builtin_amdgcn_permlane32_swap(wa.x, wb.x, false, false), ry = __builtin_amdgcn_permlane32_swap(wa.y, wb.y, false, false);
            *(GAS v4u*)(orow16 + 32 * d + 8 * r4) = (v4u){rx[0], ry[0], rx[1], ry[1]}; }
    }
}
#undef ATT_DSR
#undef ATT_WAIT
}
namespace gla {
using attn::mfma32;
constexpr int RS_ = 144;
constexpr int L_QD = 0, L_KD = L_QD + 64 * RS_, L_KST = L_KD + 64 * RS_, L_VTT = L_KST + 64 * RS_, L_EBL = L_VTT + 128 * RS_, L_GT = L_EBL + 256, L_END = L_GT + 8 * 64 * 4;
__device__ __forceinline__ bf16x8 rd2(const LAS unsigned char* p, int off2) { if (off2 == 8) return *(const LAS bf16x8*)p; const v2u lo = *(const LAS v2u*)p, hi = *(const LAS v2u*)(p + off2); const v4u v = {lo.x, lo.y, hi.x, hi.y}; return __builtin_bit_cast(bf16x8, v); }
__device__ __forceinline__ bf16x8 packacc(const f32x16& a, int half) { v4u pw;
#pragma unroll
    for (int j = 0; j < 4; ++j) pw[j] = pk2(a[8 * half + 2 * j], a[8 * half + 2 * j + 1]);
    return __builtin_bit_cast(bf16x8, pw); }

__device__ __forceinline__ void ld_unit(const float* LR, float* LD, int row0, int T, int h, int dir, const float* wd  , const float* bd  ) {
    int tid_ = threadIdx.x; asm volatile("" : "+v"(tid_));
    const int lane = tid_ & 63, w = __builtin_amdgcn_readfirstlane(tid_ >> 6), n = lane & 31, hh = lane >> 5;
    float bv[2][8], bdv[2];
#pragma unroll
    for (int cb = 0; cb < 2; ++cb) { bdv[cb] = ((const GAS float*)bd)[h * DK_A + 32 * cb + n];
#pragma unroll
        for (int i = 0; i < 8; ++i) bv[cb][i] = ((const GAS float*)wd)[(2 * i + hh) * 256 + h * DK_A + 32 * cb + n]; }
    for (int rb = w; rb < T / 32; rb += NWAVES) { float av[8]; const GAS float* lrrow = (const GAS float*)LR + (size_t)(row0 + 32 * rb + n) * 32 + dir * 16 + hh;
#pragma unroll
        for (int i = 0; i < 8; ++i) av[i] = lrrow[2 * i];
#pragma unroll
        for (int cb = 0; cb < 2; ++cb) { f32x16 acc;
#pragma unroll
            for (int r = 0; r < 16; ++r) acc[r] = 0.f;
#pragma unroll
            for (int i = 0; i < 8; ++i) acc = __builtin_amdgcn_mfma_f32_32x32x2f32(av[i], bv[cb][i], acc, 0, 0, 0);
            GAS float* ldp = (GAS float*)LD + (size_t)(row0 + 32 * rb + 4 * hh) * 512 + dir * 256 + h * DK_A + 32 * cb + n;
#pragma unroll
            for (int r = 0; r < 16; ++r) ldp[(size_t)((r & 3) + 8 * (r >> 2)) * 512] = logsigmoid_f(acc[r] + bdv[cb]) * (1.f / 16.f); } }
    VM_WAIT(); __syncthreads();
}

__device__ __forceinline__ void gla_unit(LAS unsigned char* lds, const bf16* PB, const float* LD, int row0, int T, int h, int dir,
                                         const float* s0  , float* sout  , bf16* OUT, int ldo) {
    int tid_ = threadIdx.x; asm volatile("" : "+v"(tid_));
    const int tid = tid_, lane = tid & 63, w = tid >> 6, n = lane & 31, hh = lane >> 5, dvt = w & 3, tt = w >> 2;
    const int kc = tid & 63, g = tid >> 6;
    const int dvc = tid & 127, gv = tid >> 7;
    f32x16 sacc[2];
#pragma unroll
    for (int kt = 0; kt < 2; ++kt)
#pragma unroll
        for (int r = 0; r < 16; ++r) { const int k = 32 * kt + (r & 3) + 8 * (r >> 2) + 4 * hh; sacc[kt][r] = s0 ? ((const GAS float*)s0)[k * DV_A + 32 * dvt + n] : 0.f; }
    const int NC = T / 64;
    unsigned qraw[8], kraw[8], vraw[16]; float ldr[8];
    const int sgn = dir ? -1 : 1;
    const unsigned qk0 = (unsigned)(((dir ? 63 - 8 * g : 8 * g) * PBE_W + h * DK_A + kc) * 2), v0 = (unsigned)(((dir ? 63 - 16 * gv : 16 * gv) * PBE_W + 512 + h * DV_A + dvc) * 2);
    const unsigned ld0 = (unsigned)(((dir ? 63 - 8 * g : 8 * g) * 512 + dir * 256 + h * DK_A + kc) * 4);
    const int pstep = sgn * PBE_W * 2;
#define GLA_LOAD(c_) do { const int tlo_ = dir ? T - 64 * ((c_) + 1) : 64 * (c_); \
        const GAS unsigned char* pb_ = (const GAS unsigned char*)PB + (size_t)(row0 + tlo_) * PBE_W * 2; const GAS unsigned char* lb_ = (const GAS unsigned char*)LD + (size_t)(row0 + tlo_) * 512 * 4; \
        _Pragma("unroll") for (int j = 0; j < 8; ++j) ldr[j] = *(const GAS float*)(lb_ + (ld0 + (unsigned)(j * sgn * 512 * 4))); \
        _Pragma("unroll") for (int j = 0; j < 8; ++j) { const unsigned o_ = qk0 + (unsigned)(j * pstep); qraw[j] = *(const GAS unsigned short*)(pb_ + o_); kraw[j] = *(const GAS unsigned short*)(pb_ + o_ + 512); } \
        _Pragma("unroll") for (int j = 0; j < 16; ++j) { vraw[j] = *(const GAS unsigned short*)(pb_ + (v0 + (unsigned)(j * pstep))); } } while (0)
    GLA_LOAD(0);
    for (int c = 0; c < NC; ++c) {
        float qv[8], kv[8];
#pragma unroll
        for (int j = 0; j < 8; ++j) { qv[j] = bf2f((unsigned short)qraw[j]); kv[j] = bf2f((unsigned short)kraw[j]); }
        float bc[8]; float run = 0.f;
#pragma unroll
        for (int j = 0; j < 8; ++j) { run += ldr[j]; bc[j] = run; }
        *(LAS float*)(lds + L_GT + (g * 64 + kc) * 4) = run;
        __syncthreads();
        { unsigned w4[8];
#pragma unroll
          for (int j = 0; j < 8; ++j) w4[j] = (vraw[2 * j] & 0xffffu) | (vraw[2 * j + 1] << 16);
          LAS unsigned char* d = lds + L_VTT + dvc * RS_ + 32 * gv;
          *(LAS v4u*)d = (v4u){w4[0], w4[1], w4[2], w4[3]}; *(LAS v4u*)(d + 16) = (v4u){w4[4], w4[5], w4[6], w4[7]}; }
        float pre = 0.f, bl = 0.f;
#pragma unroll
        for (int g2 = 0; g2 < 8; ++g2) { const float t = *(LAS float*)(lds + L_GT + (g2 * 64 + kc) * 4); bl += t; if (g2 < g) pre += t; }
        const float ebl = __expf(bl);
        { unsigned ks[4];
#pragma unroll
          for (int j = 0; j < 8; ++j) { const float b = pre + bc[j]; const float e = __expf(b), ei = __builtin_amdgcn_rcpf(e); const int p = 8 * g + j;
              *(LAS bf16*)(lds + L_QD + p * RS_ + kc * 2) = (bf16)f2bf(qv[j] * e); *(LAS bf16*)(lds + L_KD + p * RS_ + kc * 2) = (bf16)f2bf(kv[j] * ei);
              const float kd = kv[j] * (ebl * ei); if (j & 1) ks[j >> 1] |= f2bf(kd) << 16; else ks[j >> 1] = f2bf(kd); }
          *(LAS v4u*)(lds + L_KST + kc * RS_ + 16 * g) = (v4u){ks[0], ks[1], ks[2], ks[3]}; }
        if (g == 0) *(LAS float*)(lds + L_EBL + kc * 4) = ebl;
        __syncthreads();
        if (c + 1 < NC) GLA_LOAD(c + 1);
        f32x16 o;
#pragma unroll
        for (int r = 0; r < 16; ++r) o[r] = 0.f;
#pragma unroll
        for (int kt = 0; kt < 2; ++kt)
#pragma unroll
            for (int hf = 0; hf < 2; ++hf) { const bf16x8 a = rd2(lds + L_QD + (32 * tt + n) * RS_ + (32 * kt + 16 * hf + 4 * hh) * 2, 16); o = mfma32(a, packacc(sacc[kt], hf), o); }
#pragma unroll
        for (int st = 0; st < 2; ++st) if (st <= tt) {
            f32x16 at;
#pragma unroll
            for (int r = 0; r < 16; ++r) at[r] = 0.f;
#pragma unroll
            for (int i = 0; i < 4; ++i) { const bf16x8 a = rd2(lds + L_KD + (32 * st + n) * RS_ + (16 * i + 8 * hh) * 2, 8), b = rd2(lds + L_QD + (32 * tt + n) * RS_ + (16 * i + 8 * hh) * 2, 8); at = mfma32(a, b, at); }
            if (st == tt) {
#pragma unroll
                for (int r = 0; r < 16; ++r) { const int s = (r & 3) + 8 * (r >> 2) + 4 * hh; if (s > n) at[r] = 0.f; } }
#pragma unroll
            for (int hf = 0; hf < 2; ++hf) { const bf16x8 b = rd2(lds + L_VTT + (32 * dvt + n) * RS_ + (32 * st + 16 * hf + 4 * hh) * 2, 16); o = mfma32(packacc(at, hf), b, o); }
        }
#pragma unroll
        for (int kt = 0; kt < 2; ++kt) {
#pragma unroll
            for (int r4 = 0; r4 < 4; ++r4) { const f32x4 e4 = *(const LAS f32x4*)(lds + L_EBL + (32 * kt + 8 * r4 + 4 * hh) * 4);
#pragma unroll
                for (int j = 0; j < 4; ++j) sacc[kt][4 * r4 + j] *= e4[j]; }
#pragma unroll
            for (int i = 0; i < 4; ++i) { const bf16x8 a = rd2(lds + L_KST + (32 * kt + n) * RS_ + (16 * i + 8 * hh) * 2, 8), b = rd2(lds + L_VTT + (32 * dvt + n) * RS_ + (16 * i + 8 * hh) * 2, 8); sacc[kt] = mfma32(a, b, sacc[kt]); }
        }
        { const int tlo = dir ? T - 64 * (c + 1) : 64 * c; GAS unsigned char* ob = (GAS unsigned char*)OUT + (size_t)(row0 + tlo) * ldo * 2;
          const unsigned o0 = (unsigned)(((dir ? 63 - 32 * tt - 4 * hh : 32 * tt + 4 * hh) * ldo + 32 * dvt + n) * 2); const int ostep = sgn * ldo * 2;
#pragma unroll
          for (int r = 0; r < 16; ++r) *(GAS bf16*)(ob + (o0 + (unsigned)(((r & 3) + 8 * (r >> 2)) * ostep))) = (bf16)f2bf(o[r]); }
    }
    if (sout && tt == 0) {
#pragma unroll
        for (int kt = 0; kt < 2; ++kt)
#pragma unroll
            for (int r = 0; r < 16; ++r) { const int k = 32 * kt + (r & 3) + 8 * (r >> 2) + 4 * hh; ((GAS float*)sout)[k * DV_A + 32 * dvt + n] = sacc[kt][r]; }
    }
    __syncthreads();
#undef GLA_LOAD
}
}
#ifndef REP_LD
#define REP_LD 1
#endif
#ifndef REP_E3
#define REP_E3 1
#endif
#ifndef REP_P0A
#define REP_P0A 1
#endif
#ifndef REP_MLA
#define REP_MLA 1
#endif
#ifndef REP_MODS
#define REP_MODS 1
#endif
#ifndef REP_TR
#define REP_TR 1
#endif
#ifndef REP_CACHE
#define REP_CACHE 1
#endif
#ifndef REP_P0B
#define REP_P0B 1
#endif
#ifndef REP_GLA
#define REP_GLA 1
#endif
#ifndef REP_BAR
#define REP_BAR 0
#endif
#ifndef REP_IN
#define REP_IN 1
#endif
#ifndef REP_E2
#define REP_E2 1
#endif
#ifndef REP_UP
#define REP_UP 1
#endif
#ifndef REP_O3
#define REP_O3 1
#endif
struct Args { const float* in[30]; float* out; unsigned char* ws; };
static_assert(sizeof(Args) == 32 * 8, "Args has padding");

__device__ __forceinline__ void p0_transpose_blk(const float* W, int K, int N, bf16* WT, LAS float* scr, int k0, int n0, int dn0, const float* kgain, int lane, int imode = 0) {
    LAS bf16* t = (LAS bf16*)scr; constexpr int TS = 136;
    f32x4 v[16];
#pragma unroll
    for (int i = 0; i < 16; ++i) { const int kk = 8 * i + (lane >> 3); v[i] = *(const GAS f32x4*)(W + (size_t)(k0 + kk) * N + n0 + (lane & 7) * 4); }
    if (kgain) {
#pragma unroll
        for (int i = 0; i < 16; ++i) v[i] = v[i] * ((const GAS float*)kgain)[k0 + 8 * i + (lane >> 3)]; }
#pragma unroll
    for (int i = 0; i < 16; ++i) { const int kk = 8 * i + (lane >> 3); LAS bf16* d = t + ((lane & 7) * 4) * TS + kk; const unsigned lo = pk2(v[i][0], v[i][1]), hi = pk2(v[i][2], v[i][3]);
        d[0] = (bf16)lo; d[TS] = (bf16)(lo >> 16); d[2 * TS] = (bf16)hi; d[3 * TS] = (bf16)(hi >> 16); }
    LDS_WAIT(); asm volatile("" ::: "memory");
#pragma unroll
    for (int j = 0; j < 8; ++j) { const int n = 4 * j + (lane >> 4), c = lane & 15, dr = imode ? 32 * (n >> 4) + 8 * ((n >> 2) & 3) + (n & 3) + (imode == 2 ? 4 : 0) : n; *(GAS v4u*)(WT + (size_t)(dn0 + dr) * K + k0 + 8 * c) = *(const LAS v4u*)(t + n * TS + 8 * c); }
    LDS_WAIT(); asm volatile("" ::: "memory");
}
__device__ __forceinline__ float dpp_row_shr(float v, int n) {
    const int iv = __builtin_bit_cast(int, v); int r;
    switch (n) { case 1: r = __builtin_amdgcn_update_dpp(0, iv, 0x111, 0xf, 0xf, true); break; case 2: r = __builtin_amdgcn_update_dpp(0, iv, 0x112, 0xf, 0xf, true); break;
                 case 4: r = __builtin_amdgcn_update_dpp(0, iv, 0x114, 0xf, 0xf, true); break; default: r = __builtin_amdgcn_update_dpp(0, iv, 0x118, 0xf, 0xf, true); break; }
    return __builtin_bit_cast(float, r);
}
__device__ __forceinline__ float wave_sum_l63(float v) {
    v += dpp_row_shr(v, 1); v += dpp_row_shr(v, 2); v += dpp_row_shr(v, 4); v += dpp_row_shr(v, 8);
    v += __builtin_bit_cast(float, __builtin_amdgcn_update_dpp(0, __builtin_bit_cast(int, v), 0x142, 0xa, 0xf, false));
    v += __builtin_bit_cast(float, __builtin_amdgcn_update_dpp(0, __builtin_bit_cast(int, v), 0x143, 0xc, 0xf, false));
    return v;
}
__device__ __forceinline__ int opaque_tid() { int t = threadIdx.x; asm volatile("" : "+v"(t)); return t; }
__device__ __forceinline__ float wave_sum(float v) {
#pragma unroll
    for (int o = 1; o < 64; o <<= 1) v += __shfl_xor(v, o);
    return v;
}

__device__ __forceinline__ void p0_cache_copy(const float* src, bf16* dst, int nb, int nl, int inner, i64 t0, i64 nthr) {
    const i64 in4 = inner / 4, n4 = (i64)nb * nl * in4;
    for (i64 i0 = t0; i0 < n4; i0 += 4 * nthr) { f32x4 v[4];
#pragma unroll
        for (int u = 0; u < 4; ++u) { const i64 i = i0 + u * nthr; if (i < n4) v[u] = ((const GAS f32x4*)src)[i]; }
#pragma unroll
        for (int u = 0; u < 4; ++u) { const i64 i = i0 + u * nthr; if (i < n4) { const i64 e4 = i % in4, bl2 = i / in4, b = bl2 / nl, lq = bl2 % nl; *(GAS v2u*)(dst + ((lq * nb + b) * inner + e4 * 4)) = epi::pk4(v[u]); } } }
}

__device__ __forceinline__ void gla_combine(bf16* MIX, const bf16* OGB, const bf16* PBE, const float* gain, int r0, int nr, int h0, int nh, int wave, int lane) {
    for (int it0 = wave; it0 < nr * nh; it0 += 4 * NWAVES) { GAS unsigned* mp[4]; unsigned a[4], b[4], gq[4];
#pragma unroll
        for (int u = 0; u < 4; ++u) { const int it = it0 + u * NWAVES, row = r0 + it / nh, h = h0 + it % nh;
            mp[u] = (GAS unsigned*)(MIX + (size_t)row * MIXW + h * DV_A) + lane; a[u] = *mp[u]; b[u] = ((const GAS unsigned*)(OGB + (size_t)row * 512 + h * DV_A))[lane]; gq[u] = ((const GAS unsigned*)(PBE + (size_t)row * PBE_W + 1024 + h * DV_A))[lane]; }
        const GAS float* gg = (const GAS float*)gain + 2 * lane; const float g0 = gg[0], g1 = gg[1];
#pragma unroll
        for (int u = 0; u < 4; ++u) { const float o0 = bflo(a[u]) + bflo(b[u]), o1 = bfhi(a[u]) + bfhi(b[u]);
            const float rstd = __builtin_amdgcn_rsqf(__builtin_bit_cast(float, __builtin_amdgcn_readlane(__builtin_bit_cast(int, wave_sum_l63(o0 * o0 + o1 * o1)), 63)) * (1.f / DV_A) + EPS);
            *mp[u] = pk2(o0 * rstd * g0 * silu_f(bflo(gq[u])), o1 * rstd * g1 * silu_f(bfhi(gq[u]))); } }
}

__global__ void __launch_bounds__(NTHR, 2) mk_fwd(Args args) {
    extern __shared__ __attribute__((aligned(16))) unsigned char lds_raw[];
    LAS unsigned char* const lds0 = (LAS unsigned char*)lds_raw; LAS unsigned char* lds = lds0;
    #define MISC ((volatile LAS unsigned*)(lds + MISC_OFF))
    for (int u = threadIdx.x; u < (LDS_BYTES - LDSCTL_OFF) / 4; u += NTHR) ((LAS unsigned*)(lds + LDSCTL_OFF))[u] = 0u;
    __syncthreads();
    if (threadIdx.x == 0) {
#pragma unroll
        for (int k = 0; k < 30; ++k) ((LAS unsigned long long*)(lds + ARGS_OFF))[k] = (unsigned long long)args.in[k];
        ((LAS unsigned long long*)(lds + ARGS_OFF))[30] = (unsigned long long)args.out; ((LAS unsigned long long*)(lds + ARGS_OFF))[31] = (unsigned long long)args.ws;
    }
    __syncthreads();
    { XcdBarrier b0 = xcd_barrier_post((unsigned*)((gu32*)(args.ws + WS_CTL) + CW_BAR), MISC + 8); if (threadIdx.x == 0) MISC[10] = b0.x; }
    __syncthreads();
#define GRID_BAR() do { XcdBarrier b_; b_.bar = (unsigned*)((gu32*)(WSB + WS_CTL) + CW_BAR); b_.x = (unsigned)__builtin_amdgcn_readfirstlane((int)MISC[10]); b_.st = MISC + 8; xcd_barrier(b_); { unsigned o_ = 0; asm volatile("" : "+s"(o_)); lds = lds0 + o_; } } while (0)
#define TID (opaque_tid())
#define LANE (TID & 63)
#define WAVE (__builtin_amdgcn_readfirstlane(TID >> 6))
#define GSIZE ((int)gridDim.x)
#define VCU ((int)((blockIdx.x & 7) * (gridDim.x >> 3) + (blockIdx.x >> 3)))
#define GTHREADS(i, n) for (i64 i = (i64)blockIdx.x * NTHR + TID, _n = (n); i < _n; i += (i64)GSIZE * NTHR)
#define GWAVES(i, n) for (i64 i = (i64)blockIdx.x * NWAVES + WAVE, _n = (n); i < _n; i += (i64)GSIZE * NWAVES)
#define GEMM(EPI, Aptr, LDA, Bptr, LDB, Mv, Nv, Kv) GEMM_SUB(EPI, Aptr, LDA, Bptr, LDB, Mv, Nv, Kv, 0, GSIZE)
#define GEMM_SUB(EPI, Aptr, LDA, Bptr, LDB, Mv, Nv, Kv, W0, WN) do { int k_ = (Kv); asm volatile("" : "+s"(k_));     \
        const pg8::Gemm g_{(const pg8::bf16_t*)(Aptr), (const pg8::bf16_t*)(Bptr), (Mv), (Nv), k_, (LDA), (LDB)}; int G_ = (WN), c_ = (int)blockIdx.x - (W0); if (c_ >= G_) c_ = -1; asm volatile("" : "+s"(G_), "+s"(c_));     \
        pg8::StaticOrder S_; S_.init((Mv), (Nv), G_, c_); \
        pg8::gemm_phase<decltype(EPI), pg8::StaticOrder, true, true>(lds, g_, S_, (EPI)); } while (0)
#define GEMM_SUB_RS4(EPI, SSQP, INVN, Aptr, LDA, Bptr, LDB, Mv, Nv, Kv, W0, WN) do { int k_ = (Kv); asm volatile("" : "+s"(k_));     \
        const pg8::Gemm g_{(const pg8::bf16_t*)(Aptr), (const pg8::bf16_t*)(Bptr), (Mv), (Nv), k_, (LDA), (LDB)}; int G_ = (WN), c_ = (int)blockIdx.x - (W0); if (c_ >= G_) c_ = -1; asm volatile("" : "+s"(G_), "+s"(c_));     \
        pg8::StaticOrder S_; S_.init((Mv), (Nv), G_, c_); epi::rstd_prepass<4>(lds, (SSQP), S_, (INVN)); \
        pg8::gemm_phase<decltype(EPI), pg8::StaticOrder, true, true>(lds, g_, S_, (EPI)); } while (0)
#define GEMM_RS(EPI, SSQP, SHWP, Aptr, LDA, Bptr, LDB, Mv, Nv, Kv) do { int k_ = (Kv); asm volatile("" : "+s"(k_));     \
        const pg8::Gemm g_{(const pg8::bf16_t*)(Aptr), (const pg8::bf16_t*)(Bptr), (Mv), (Nv), k_, (LDA), (LDB)}; int G_ = GSIZE, c_ = (int)blockIdx.x; asm volatile("" : "+s"(G_), "+s"(c_));     \
        pg8::StaticOrder S_; S_.init((Mv), (Nv), G_, c_); epi::rstd_prepass<16, 1>(lds, (SSQP), S_, 1.f / D, (SHWP));     \
        pg8::gemm_phase<decltype(EPI), pg8::StaticOrder, true, true>(lds, g_, S_, (EPI)); } while (0)

    for (int rep_ = 0; rep_ < REP_P0A; ++rep_) {
        LAS float* sv = (LAS float*)lds;
        for (int e = TID; e < 9 * D; e += NTHR) { const int j = e / D, k = e % D; sv[e] = silu_f(j == 0 ? c_ctx[k] : cvec[(size_t)(j - 1) * D + k]); }
        __syncthreads();
        for (int rm_ = 0; rm_ < REP_MODS; ++rm_) { LAS float* part = (LAS float*)(lds + 40960);
          for (int task = blockIdx.x; task < DEPTH * (6 * D / 32); task += GSIZE) { const int l = task / (6 * D / 32), n0 = (task % (6 * D / 32)) * 32, lane = LANE, ks = 2 * WAVE + (lane >> 5), cl = lane & 31;
              const GAS float* w = (const GAS float*)w_ada + ((size_t)l * D + ks * 64) * 6 * D + n0 + cl; float a[9];
#pragma unroll
              for (int j = 0; j < 9; ++j) a[j] = 0.f;
              for (int kc = 0; kc < 64; kc += 32) { float wv[32];
#pragma unroll
                  for (int k2 = 0; k2 < 32; ++k2) wv[k2] = w[(size_t)(kc + k2) * 6 * D];
#pragma unroll
                  for (int k4 = 0; k4 < 32; k4 += 4)
#pragma unroll
                      for (int j = 0; j < 9; ++j) { const f32x4 s4 = *(const LAS f32x4*)(sv + j * D + ks * 64 + kc + k4); a[j] += (s4[0] * wv[k4] + s4[1] * wv[k4 + 1]) + (s4[2] * wv[k4 + 2] + s4[3] * wv[k4 + 3]); } }
#pragma unroll
              for (int j = 0; j < 9; ++j) part[(ks * 9 + j) * 32 + cl] = a[j];
              __syncthreads();
              for (int e = TID; e < 9 * 32; e += NTHR) { const int j = e >> 5, ln = e & 31; float s = b_ada[(size_t)l * 6 * D + n0 + ln];
#pragma unroll
                  for (int q = 0; q < 16; ++q) s += part[(q * 9 + j) * 32 + ln];
                  WSP(float, WS_MODS)[((size_t)l * 9 + j) * 6 * D + n0 + ln] = s; }
              __syncthreads(); } }
        __syncthreads();
        LAS float* scr = (LAS float*)(lds + WAVE * 16384);
        constexpr int I_INE = (D / 128) * (IN_EVEN / 32), I_OUT = (MIXW / 128) * (D / 32), I_UQ = (Q_RANK / 128) * (QB_W / 32), I_UKV = (KV_RANK / 128) * (KV_W / 32), I_INO = (D / 128) * (IN_ODD / 32),
                      I_UP = (D / 128) * (2 * D_FF / 32), I_DN = (D_FF / 128) * (D / 32);
        constexpr int NITEMS = 2 * (I_INE + I_OUT + I_UQ + 2 * I_UKV + I_INO + I_OUT) + 4 * (I_UP + I_DN);
        for (int rt_ = 0; rt_ < REP_TR; ++rt_) GWAVES(it, NITEMS) {
            int r = (int)it; const int lane = LANE;
            if (r < 2 * I_INE) { const int li = r / I_INE, q = r % I_INE, nblk = IN_EVEN / 32, kb = q / nblk, sb = q % nblk, db = sb == 48 ? 66 : (sb > 48 ? sb - 1 : sb);
                p0_transpose_blk(w_in_even + (size_t)li * D * IN_EVEN, D, IN_EVEN, WSP(bf16, WS_WINE) + (size_t)li * IN_EVEN_P * D, scr, 128 * kb, 32 * sb, 32 * db, nullptr, lane); continue; } r -= 2 * I_INE;
            if (r < 2 * I_OUT) { const int li = r / I_OUT, q = r % I_OUT, nblk = D / 32; p0_transpose_blk(w_out_even + (size_t)li * MIXW * D, MIXW, D, WSP(bf16, WS_WOUTE) + (size_t)li * D * MIXW, scr, 128 * (q / nblk), 32 * (q % nblk), 32 * (q % nblk), nullptr, lane); continue; } r -= 2 * I_OUT;
            if (r < 2 * I_UQ) { const int li = r / I_UQ, q = r % I_UQ, nblk = QB_W / 32, kb = q / nblk, sb = q % nblk, hq = sb / 6, j = sb % 6, db = j < 4 ? 4 * hq + j : 16 + 2 * hq + (j - 4);
                p0_transpose_blk(mla_w_uq + (size_t)li * Q_RANK * QB_W, Q_RANK, QB_W, WSP(bf16, WS_WUQ) + (size_t)li * QB_W * Q_RANK, scr, 128 * kb, 32 * sb, 32 * db, mla_q_norm + (size_t)li * Q_RANK, lane); continue; } r -= 2 * I_UQ;
            if (r < 4 * I_UKV) { const int fold = r < 2 * I_UKV; const int r2 = fold ? r : r - 2 * I_UKV; const int li = r2 / I_UKV, q = r2 % I_UKV, nblk = KV_W / 32, kb = q / nblk, sb = q % nblk, hq = sb / 8, j = sb % 8, db = j < 4 ? 4 * hq + j : 16 + 4 * hq + (j - 4);
                p0_transpose_blk(mla_w_ukv + (size_t)li * KV_RANK * KV_W, KV_RANK, KV_W, WSP(bf16, fold ? WS_WUKV : WS_WUKVC) + (size_t)li * KV_W * KV_RANK, scr, 128 * kb, 32 * sb, 32 * db, fold ? mla_kv_norm + (size_t)li * KV_RANK : nullptr, lane); continue; } r -= 4 * I_UKV;
            if (r < 2 * I_INO) { const int li = r / I_INO, q = r % I_INO, nblk = IN_ODD / 32; p0_transpose_blk(w_in_odd + (size_t)li * D * IN_ODD, D, IN_ODD, WSP(bf16, WS_WINO) + (size_t)li * IN_ODD * D, scr, 128 * (q / nblk), 32 * (q % nblk), 32 * (q % nblk), nullptr, lane); continue; } r -= 2 * I_INO;
            if (r < 2 * I_OUT) { const int li = r / I_OUT, q = r % I_OUT, nblk = D / 32; p0_transpose_blk(w_out_odd + (size_t)li * MIXW * D, MIXW, D, WSP(bf16, WS_WOUTO) + (size_t)li * D * MIXW, scr, 128 * (q / nblk), 32 * (q % nblk), 32 * (q % nblk), nullptr, lane); continue; } r -= 2 * I_OUT;
            if (r < 4 * I_UP) { const int l = r / I_UP, q = r % I_UP, nblk = 2 * D_FF / 32, sb = q % nblk, hb = D_FF / 32, isg = sb >= hb, ab = isg ? sb - hb : sb, tail = ab >= UP_FULL_N / 64;
                const int drow = tail ? UP_FULL_N + 64 * (ab - UP_FULL_N / 64) : 32 * ((ab >> 2) * 8 + 4 * isg + (ab & 3));
                p0_transpose_blk(ffn_w_up + (size_t)l * D * 2 * D_FF, D, 2 * D_FF, WSP(bf16, WS_WUP) + (size_t)l * 2 * D_FF * D, scr, 128 * (q / nblk), 32 * sb, drow, nullptr, lane, tail ? 1 + isg : 0); continue; } r -= 4 * I_UP;
            { const int l = r / I_DN, q = r % I_DN, nblk = D / 32; p0_transpose_blk(ffn_w_down + (size_t)l * D_FF * D, D_FF, D, WSP(bf16, WS_WDN) + (size_t)l * D * D_FF, scr, 128 * (q / nblk), 32 * (q % nblk), 32 * (q % nblk), nullptr, lane); }
        }
        GTHREADS(i, (i64)2 * (IN_EVEN_P - IN_EVEN) * D) { const i64 per = (i64)(IN_EVEN_P - IN_EVEN) * D; WSP(bf16, WS_WINE)[(i / per) * IN_EVEN_P * D + (i64)IN_EVEN * D + i % per] = 0; }
        for (int rc_ = 0; rc_ < REP_CACHE; ++rc_) {
        { const i64 t0 = (i64)blockIdx.x * NTHR + TID, nthr = (i64)GSIZE * NTHR;
          p0_cache_copy(cache_mla_ckv, WSP(bf16, WS_CCKV), DEC_BATCH, N_EVEN, PAST * KV_RANK, t0, nthr);
          p0_cache_copy(cache_mla_krope, WSP(bf16, WS_KRC), DEC_BATCH, N_EVEN, PAST * ROPE, t0, nthr);
          p0_cache_copy(cache_diff_k, WSP(bf16, WS_KDC), DEC_BATCH, N_ODD, PAST * 1024, t0, nthr); }
        { const i64 nv = (i64)N_ODD * DEC_BATCH * H_C * 128 * (PAST / 8), nthr = (i64)GSIZE * NTHR;
          for (i64 i0 = (i64)blockIdx.x * NTHR + TID; i0 < nv; i0 += 2 * nthr) { float sv[2][8];
#pragma unroll
            for (int u = 0; u < 2; ++u) { const i64 i = i0 + u * nthr; if (i < nv) { const int dv = (int)(i % 128), hq = (int)((i / 128) % H_C), kb = (int)((i / (128 * H_C)) % (PAST / 8)); const i64 b = (i / (128 * H_C * (PAST / 8))) % DEC_BATCH, lq = i / ((i64)128 * H_C * (PAST / 8) * DEC_BATCH);
                const GAS float* src = (const GAS float*)cache_diff_v + ((b * N_ODD + lq) * PAST + 8 * kb) * 1024 + hq * 128 + dv;
#pragma unroll
                for (int k = 0; k < 8; ++k) sv[u][k] = src[1024 * k]; } }
#pragma unroll
            for (int u = 0; u < 2; ++u) { const i64 i = i0 + u * nthr; if (i < nv) { const int dv = (int)(i % 128), hq = (int)((i / 128) % H_C), kb = (int)((i / (128 * H_C)) % (PAST / 8)); const i64 b = (i / (128 * H_C * (PAST / 8))) % DEC_BATCH, lq = i / ((i64)128 * H_C * (PAST / 8) * DEC_BATCH);
                *(GAS v4u*)(WSP(bf16, WS_VDC) + (((lq * DEC_BATCH + b) * H_C + hq) * 128 + dv) * PAST + 8 * kb) = (v4u){pk2(sv[u][0], sv[u][1]), pk2(sv[u][2], sv[u][3]), pk2(sv[u][4], sv[u][5]), pk2(sv[u][6], sv[u][7])}; } } } }
        }
    }
    GRID_BAR();
    for (int rb_ = 0; rb_ < REP_P0B; ++rb_) {
        { const int combo = VCU & 7, l = combo >> 1, sub = combo & 1, slice = VCU >> 3, nsl = GSIZE >> 3, lane = LANE;
          float shr[9][16];
#pragma unroll
          for (int j = 0; j < 9; ++j) { const GAS f32x4* sp = (const GAS f32x4*)(WSP(float, WS_MODS) + ((size_t)l * 9 + j) * 6 * D + sub * 3 * D + lane * 16);
#pragma unroll
              for (int q = 0; q < 4; ++q) { const f32x4 t = sp[q]; shr[j][4 * q] = t[0]; shr[j][4 * q + 1] = t[1]; shr[j][4 * q + 2] = t[2]; shr[j][4 * q + 3] = t[3]; } }
          const int N = sub ? 2 * D_FF : ((l & 1) ? IN_ODD : IN_EVEN_P);
          const bf16* Wt = sub ? WSP(bf16, WS_WUP) + (size_t)l * 2 * D_FF * D : ((l & 1) ? WSP(bf16, WS_WINO) + (size_t)(l >> 1) * IN_ODD * D : WSP(bf16, WS_WINE) + (size_t)(l >> 1) * IN_EVEN_P * D);
          float* dst = WSP(float, WS_SHW) + (size_t)(l * 2 + sub) * 9 * 2 * D_FF;
          for (int n0 = slice * NWAVES + WAVE; n0 < N; n0 += 2 * nsl * NWAVES) {
              const int n1 = n0 + nsl * NWAVES, n1c = n1 < N ? n1 : n0;
              const v4u wa0 = *(const GAS v4u*)(Wt + (size_t)n0 * D + lane * 16), wa1 = *(const GAS v4u*)(Wt + (size_t)n0 * D + lane * 16 + 8), wb0 = *(const GAS v4u*)(Wt + (size_t)n1c * D + lane * 16), wb1 = *(const GAS v4u*)(Wt + (size_t)n1c * D + lane * 16 + 8);
#pragma unroll
              for (int u = 0; u < 2; ++u) { const v4u w0 = u ? wb0 : wa0, w1 = u ? wb1 : wa1; const int n = u ? n1 : n0;
                  float wv[16];
#pragma unroll
                  for (int q = 0; q < 4; ++q) { wv[2 * q] = bflo(w0[q]); wv[2 * q + 1] = bfhi(w0[q]); wv[8 + 2 * q] = bflo(w1[q]); wv[8 + 2 * q + 1] = bfhi(w1[q]); }
#pragma unroll
                  for (int j = 0; j < 9; ++j) { float sacc = 0.f;
#pragma unroll
                      for (int q = 0; q < 16; ++q) sacc += wv[q] * shr[j][q];
                      sacc = wave_sum_l63(sacc); if (lane == 63 && n < N) ((GAS float*)dst)[(size_t)j * 2 * D_FF + n] = sacc; } }
          } }
        GTHREADS(i, (i64)DEPTH * 2 * 9 * D) { const int c = (int)(i % D), j = (int)((i / D) % 9), dn = (int)((i / (9 * D)) & 1), l = (int)(i / (18 * D)), ln = l + 1 < DEPTH ? l + 1 : l;
            const float g = norm_gain[(size_t)(dn ? ln * 2 : l * 2 + 1) * D + c], sc = dn ? WSP(float, WS_MODS)[((size_t)ln * 9 + j) * 6 * D + D + c] : WSP(float, WS_MODS)[((size_t)l * 9 + j) * 6 * D + 4 * D + c];
            WSP(float, WS_GS)[i] = g * (1.f + sc); }
        { const int lane2 = LANE; f32x4 gq[4];
#pragma unroll
          for (int q = 0; q < 4; ++q) gq[q] = *(const GAS f32x4*)(norm_gain + 256 * q + 4 * lane2);
          for (i64 row0 = (i64)blockIdx.x * NWAVES + WAVE; row0 < M_ALL; row0 += (i64)4 * GSIZE * NWAVES) { f32x4 x[4][4], sc[4][4];
#pragma unroll
            for (int u = 0; u < 4; ++u) { const i64 row = row0 + (i64)u * GSIZE * NWAVES; const float* xr = row < M_CTX ? x_prompt + (size_t)row * D : x_sample + (size_t)(row - M_CTX) * D; const int mj = row < M_CTX ? 0 : 1 + (int)((row - M_CTX) >> 10);
                const float* scv = WSP(float, WS_MODS) + (size_t)mj * 6 * D + D;
#pragma unroll
                for (int q = 0; q < 4; ++q) { x[u][q] = *(const GAS f32x4*)(xr + 256 * q + 4 * lane2); sc[u][q] = *(const GAS f32x4*)(scv + 256 * q + 4 * lane2); } }
#pragma unroll
            for (int u = 0; u < 4; ++u) { const i64 row = row0 + (i64)u * GSIZE * NWAVES; float s = 0.f;
#pragma unroll
                for (int q = 0; q < 4; ++q) { const f32x4 xv = x[u][q]; s += (xv[0] * xv[0] + xv[1] * xv[1]) + (xv[2] * xv[2] + xv[3] * xv[3]); *(GAS v2u*)(WSP(bf16, WS_XG) + (size_t)row * D + 256 * q + 4 * lane2) = epi::pk4(xv * (gq[q] * (sc[u][q] + 1.f))); }
                s = wave_sum(s); if (lane2 < 16) WSP(float, WS_SSQ)[(size_t)row * 16 + lane2] = lane2 == 0 ? s : 0.f; } } }
        for (int li = 0; li < N_EVEN; ++li) { epi::EpiKV<1> E{lds, li};
            GEMM_SUB(E, WSP(bf16, WS_CCKV) + (size_t)li * CROWS * KV_RANK, KV_RANK, WSP(bf16, WS_WUKVC) + (size_t)li * KV_W * KV_RANK, KV_RANK, CROWS, KV_W, KV_RANK, 64 * li, 64); }
    }
    GRID_BAR();

    for (int l = 0; l < DEPTH; ++l) {
        const int li = l >> 1;
        if ((l & 1) == 0) {
            for (int rep_ = 0; rep_ < REP_IN; ++rep_) { epi::EpiInE<false> E{lds, li, l, 0};
              GEMM_RS(E, WSP(float, WS_SSQ), WSP(float, WS_SHW) + (size_t)(l * 2) * 9 * 2 * D_FF, WSP(bf16, WS_XG), D, WSP(bf16, WS_WINE) + (size_t)li * IN_EVEN_P * D, D, M_ALL, 2048, D); }
            GRID_BAR();
            { epi::EpiInE<true> E{lds, li, l, 8}; int k_ = D; asm volatile("" : "+s"(k_));
              const pg8::Gemm g_{(const pg8::bf16_t*)WSP(bf16, WS_XG), (const pg8::bf16_t*)(WSP(bf16, WS_WINE) + ((size_t)li * IN_EVEN_P + 2048) * D), M_ALL, 128, k_, D, D};
              int G_ = 64, c_ = (int)blockIdx.x; if (c_ >= G_) c_ = -1; asm volatile("" : "+s"(G_), "+s"(c_));
              pg8::StaticOrder S_; S_.init(M_ALL, 256, G_, c_); epi::rstd_prepass<16, 1>(lds, WSP(float, WS_SSQ), S_, 1.f / D, WSP(float, WS_SHW) + (size_t)(l * 2) * 9 * 2 * D_FF, 8);
              pg8::gemm_phase<decltype(E), pg8::StaticOrder, true, true, 1>(lds, g_, S_, E); }
            { int G_ = GSIZE - 64, c_ = (int)blockIdx.x - 64; if (c_ >= G_) c_ = -1; asm volatile("" : "+s"(G_), "+s"(c_));
              int G2_ = GSIZE, c2_ = (int)blockIdx.x; asm volatile("" : "+s"(G2_), "+s"(c2_));
              pg8::StaticOrder Sq_, Skv_; Sq_.init(M_ALL, QB_W, G_, c_); Skv_.init(M_ALL, KV_W, G2_, c2_);
              if (c_ >= 0) epi::rstd_prepass<4, 1>(lds, WSP(float, WS_SSQC), Sq_, 1.f / Q_RANK, nullptr, 0, 0, false);
              epi::rstd_prepass<4, 1>(lds, WSP(float, WS_SSQC) + (size_t)M_ALL * 4, Skv_, 1.f / KV_RANK, nullptr, 0, 2, true); }
            for (int rep_ = 0; rep_ < REP_E2; ++rep_) { epi::EpiUq E{lds}; GEMM_SUB(E, WSP(bf16, WS_PBE) + 1536, PBE_W, WSP(bf16, WS_WUQ) + (size_t)li * QB_W * Q_RANK, Q_RANK, M_ALL, QB_W, Q_RANK, 64, GSIZE - 64); }
            for (int rep_ = 0; rep_ < REP_E2; ++rep_) { epi::EpiKV<0> E{lds, li}; GEMM(E, WSP(bf16, WS_PBE) + 1792, PBE_W, WSP(bf16, WS_WUKV) + (size_t)li * KV_W * KV_RANK, KV_RANK, M_ALL, KV_W, KV_RANK); }
            { const int lane = LANE; const f32x4 kg = *(const GAS f32x4*)(mla_kv_norm + (size_t)li * KV_RANK + 4 * lane);
              for (i64 row0 = (i64)blockIdx.x * NWAVES + WAVE; row0 < M_CTX; row0 += (i64)4 * GSIZE * NWAVES) { f32x4 ov[4], pq[4];
#pragma unroll
                for (int u = 0; u < 4; ++u) { const i64 row = row0 + (i64)u * GSIZE * NWAVES; ov[u] = *(const GAS f32x4*)(o_ckv + (((size_t)(row >> 8) * N_EVEN + li) * SEQ + (row & 255)) * KV_RANK + 4 * lane); pq[u] = *(const GAS f32x4*)(WSP(float, WS_SSQC) + ((size_t)M_ALL + row) * 4); }
#pragma unroll
                for (int u = 0; u < 4; ++u) { const i64 row = row0 + (i64)u * GSIZE * NWAVES; const float rstd = __builtin_amdgcn_rsqf(((pq[u][0] + pq[u][1]) + (pq[u][2] + pq[u][3])) * (1.f / KV_RANK) + EPS);
                    *(GAS f32x4*)(o_ckv + (((size_t)(row >> 8) * N_EVEN + li) * SEQ + (row & 255)) * KV_RANK + 4 * lane) = ov[u] * rstd * kg; } } }
            GRID_BAR();
            for (int rep_ = 0; rep_ < REP_E3; ++rep_) { const int v = VCU;
              const int ng = v < 128 ? 0 : (v < 192 ? 1 : 4);
              for (int rg_ = 0; rg_ < REP_GLA; ++rg_) for (int q = 0; q < ng; ++q) {
                  const int g = v < 192 ? v - 128 : 4 * (v - 192) + q; const int B = v < 192 ? BATCH + (g >> 3) : (g >> 3), h = (g >> 1) & 3, dir = g & 1;
                  const int lat = B >= BATCH, bl = B - BATCH, T = lat ? DEC_SEQ : SEQ, row0 = lat ? M_CTX + bl * DEC_SEQ : B * SEQ;
                  const float* s0 = lat ? state_gla + ((((size_t)bl * N_EVEN + li) * 2 + dir) * H_A + h) * DK_A * DV_A : nullptr;
                  float* so = lat ? nullptr : o_state + ((((size_t)B * N_EVEN + li) * 2 + dir) * H_A + h) * DK_A * DV_A;
                  bf16* out = dir ? WSP(bf16, WS_OGB) + h * DV_A : WSP(bf16, WS_MIX) + h * DV_A;
                  for (int rl_ = 0; rl_ < REP_LD; ++rl_) gla::ld_unit(WSP(float, WS_LR), WSP(float, WS_LD), row0, T, h, dir, gla_w_decay + ((size_t)li * 2 + dir) * GLA_LR * 256, gla_b_decay + ((size_t)li * 2 + dir) * 256);
                  gla::gla_unit(lds, WSP(bf16, WS_PBE), WSP(float, WS_LD), row0, T, h, dir, s0, so, out, dir ? 512 : MIXW); }
              if (v >= 192) { VM_WAIT(); __syncthreads(); const int vv = v - 192;
                  gla_combine(WSP(bf16, WS_MIX), WSP(bf16, WS_OGB), WSP(bf16, WS_PBE), gla_norm + (size_t)li * DV_A, (vv >> 1) * SEQ, SEQ, (2 * vv) & 3, 2, WAVE, LANE); }
              else if (v >= 128) { const int g = v - 128, bl = g >> 3, h = (g >> 1) & 3, dir = g & 1;
                  VM_WAIT(); __syncthreads();
                  if (TID == 0) { unsigned* pc = (unsigned*)((gu32*)(WSB + WS_CTL) + CW_PAIR + li * 32 + (g >> 1)); const unsigned target = 2u * (unsigned)(rep_ + 1);
                      __builtin_amdgcn_fence(__ATOMIC_RELEASE, "agent"); VM_WAIT();
                      (void)xb_add(pc, 1u); XB_SPIN(xb_ld(pc) < target, (unsigned*)((gu32*)(WSB + WS_CTL) + CW_BAR));
                      __builtin_amdgcn_fence(__ATOMIC_ACQUIRE, "agent"); VM_WAIT(); }
                  __syncthreads();
                  gla_combine(WSP(bf16, WS_MIX), WSP(bf16, WS_OGB), WSP(bf16, WS_PBE), gla_norm + (size_t)li * DV_A, M_CTX + bl * DEC_SEQ + dir * (DEC_SEQ / 2), DEC_SEQ / 2, h, 1, WAVE, LANE); }
              for (int rm2_ = 0; rm2_ < (v < 128 ? 2 * REP_MLA : 0); ++rm2_) { const int ctx = (rm2_ + (((int)blockIdx.x >> 3) & 1)) & 1;
                const int B = ctx ? (v >> 2) : BATCH + (v >> 4), h = ctx ? v & 3 : (v >> 2) & 3, qt = ctx ? 0 : v & 3;
                const int lat = B >= BATCH, bl = B - BATCH, T = lat ? DEC_SEQ : SEQ, row0 = lat ? M_CTX + bl * DEC_SEQ : B * SEQ;
                attn::KSrc cs{WSP(bf16, WS_KNC) + ((size_t)li * CROWS + (size_t)bl * PAST) * 512 + h * 128, WSP(bf16, WS_KRC) + ((size_t)li * CROWS + (size_t)bl * PAST) * ROPE, WSP(bf16, WS_VTC) + ((size_t)li * CROWS + (size_t)bl * PAST) * 512 + (size_t)h * 128 * PAST, 512, ROPE, PAST, 0};
                attn::KSrc ns{WSP(bf16, WS_KN) + (size_t)row0 * 512 + h * 128, WSP(bf16, WS_KR) + (size_t)row0 * ROPE, WSP(bf16, WS_VT) + (size_t)row0 * 512 + (size_t)h * 128 * T, 512, ROPE, T, 0};
                const bf16* q = WSP(bf16, WS_QBUF) + (size_t)(row0 + 256 * qt) * QB_W;
                attn::attn_unit<192>(lds, q + h * 128, q + 512 + h * 64, QB_W, cs, lat ? PAST / 64 : 0, ns, T / 64, WSP(bf16, WS_MIX) + (size_t)(row0 + 256 * qt) * MIXW + 512 + h * 128, MIXW); } }
            GRID_BAR();
        } else {
            for (int rep_ = 0; rep_ < REP_IN; ++rep_) { epi::EpiInO E{lds, li, l};
              GEMM_RS(E, WSP(float, WS_SSQ), WSP(float, WS_SHW) + (size_t)(l * 2) * 9 * 2 * D_FF, WSP(bf16, WS_XG), D, WSP(bf16, WS_WINO) + (size_t)li * IN_ODD * D, D, M_ALL, IN_ODD, D); }
            GRID_BAR();
            for (int rep_ = 0; rep_ < REP_O3; ++rep_) { const int v = VCU, lane = LANE; const float* lp = diff_lambda + (size_t)li * 4 * DH_C; const float lam_init = 0.8f - 0.6f * __expf(-0.3f * (float)l);
              const float lam = __expf(wave_sum(lp[lane] * lp[DH_C + lane])) - __expf(wave_sum(lp[2 * DH_C + lane] * lp[3 * DH_C + lane])) + lam_init;
              const int ctx_first = ((int)blockIdx.x >> 3) & 1;
              for (int rep0 = 0; rep0 < 4; ++rep0) { const int rep = (rep0 + 2 * ctx_first) & 3;
                  const int lat = rep < 2, map = rep & 1;
                  const int B = lat ? BATCH + (v >> 5) : (v >> 3), h = lat ? (v >> 2) & 7 : v & 7, qt = lat ? v & 3 : 0;
                  const int bl = B - BATCH, T = lat ? DEC_SEQ : SEQ, row0 = lat ? M_CTX + bl * DEC_SEQ : B * SEQ;
                  attn::KSrc cs{WSP(bf16, WS_KDC) + ((size_t)li * CROWS + (size_t)bl * PAST) * 1024 + h * 128 + map * 64, nullptr, WSP(bf16, WS_VDC) + ((size_t)li * CROWS + (size_t)bl * PAST) * 1024 + (size_t)h * 128 * PAST, 1024, 0, PAST, 0};
                  attn::KSrc ns{WSP(bf16, WS_PBO) + (size_t)row0 * PBO_W + 1024 + h * 128 + map * 64, nullptr, WSP(bf16, WS_VD) + (size_t)row0 * 1024 + (size_t)h * 128 * T, PBO_W, 0, T, 0};
                  const bf16* q = WSP(bf16, WS_PBO) + (size_t)(row0 + 256 * qt) * PBO_W + h * 128 + map * 64; bf16* o = WSP(bf16, WS_MIX) + (size_t)(row0 + 256 * qt) * MIXW + h * 128;
                  if (map == 0) attn::attn_unit<64, false>(lds, q, nullptr, PBO_W, cs, lat ? PAST / 64 : 0, ns, T / 64, o, MIXW);
                  else attn::attn_unit<64, true>(lds, q, nullptr, PBO_W, cs, lat ? PAST / 64 : 0, ns, T / 64, o, MIXW, lam, 1.f - lam_init, diff_norm + (size_t)li * 128); } }
            GRID_BAR();
        }
        if (l == 0) { epi::EpiOut<true> E{lds, l, 0, 0};
          GEMM(E, WSP(bf16, WS_MIX), MIXW, ((l & 1) ? WSP(bf16, WS_WOUTO) : WSP(bf16, WS_WOUTE)) + (size_t)li * D * MIXW, MIXW, M_ALL, D, MIXW); }
        else { epi::EpiOut<false> E{lds, l, 0, 0};
          GEMM(E, WSP(bf16, WS_MIX), MIXW, ((l & 1) ? WSP(bf16, WS_WOUTO) : WSP(bf16, WS_WOUTE)) + (size_t)li * D * MIXW, MIXW, M_ALL, D, MIXW); }
        GRID_BAR();
        for (int rep_ = 0; rep_ < REP_UP; ++rep_) { int tail_first = ((int)blockIdx.x >> 3) & 1; asm volatile("" : "+s"(tail_first));
          { pg8::StaticOrder S0_; S0_.init(M_ALL, UP_FULL_N, GSIZE, (int)blockIdx.x); epi::rstd_prepass<16, 1>(lds, WSP(float, WS_SSQ) + (size_t)M_ALL * 16, S0_, 1.f / D); }
          if (tail_first) {
          { epi::EpiUpConv<true> E{lds, l}; int k_ = D; asm volatile("" : "+s"(k_));
            const pg8::Gemm g_{(const pg8::bf16_t*)WSP(bf16, WS_XG), (const pg8::bf16_t*)(WSP(bf16, WS_WUP) + ((size_t)l * 2 * D_FF + UP_FULL_N) * D), M_ALL, 2 * D_FF - UP_FULL_N, k_, D, D};
            int G_ = GSIZE, c_ = (int)blockIdx.x; asm volatile("" : "+s"(G_), "+s"(c_));
            pg8::StaticOrder S_; S_.init(M_ALL, 2 * (2 * D_FF - UP_FULL_N), G_, c_);
            pg8::gemm_phase<decltype(E), pg8::StaticOrder, true, true, 1>(lds, g_, S_, E); } }
            { epi::EpiUpConv<false> E{lds, l}; GEMM(E, WSP(bf16, WS_XG), D, WSP(bf16, WS_WUP) + (size_t)l * 2 * D_FF * D, D, M_ALL, UP_FULL_N, D); }
          if (!tail_first) {
          { epi::EpiUpConv<true> E{lds, l}; int k_ = D; asm volatile("" : "+s"(k_));
            const pg8::Gemm g_{(const pg8::bf16_t*)WSP(bf16, WS_XG), (const pg8::bf16_t*)(WSP(bf16, WS_WUP) + ((size_t)l * 2 * D_FF + UP_FULL_N) * D), M_ALL, 2 * D_FF - UP_FULL_N, k_, D, D};
            int G_ = GSIZE, c_ = (int)blockIdx.x; asm volatile("" : "+s"(G_), "+s"(c_));
            pg8::StaticOrder S_; S_.init(M_ALL, 2 * (2 * D_FF - UP_FULL_N), G_, c_);
            pg8::gemm_phase<decltype(E), pg8::StaticOrder, true, true, 1>(lds, g_, S_, E); } } }
        GRID_BAR();
        { const float* cw = ffn_conv_w + (size_t)l * 3 * 2 * D_FF; const float* cb = ffn_conv_b + (size_t)l * 2 * D_FF;
          pg8::StaticOrder Sd; Sd.init(M_ALL, D, GSIZE, (int)blockIdx.x); pg8::Unit ud; ud.pm = 0; ud.pn = 0; ud.idx = 0;
          if (Sd.next(0, ud)) { const int pm = ud.pm;
          const int inseq = pm >= 32, ps = inseq ? (pm - 32) & 3 : 0;
          const size_t RW = 2 * D_FF; const f32x4 z = {0.f, 0.f, 0.f, 0.f};
          for (int i0 = TID; i0 < D_FF / 4; i0 += NTHR) { const int f = i0 * 4;
              const GAS float* ub = (const GAS float*)WSP(float, WS_UB) + (size_t)pm * 8 * 2 * D_FF + f;
              f32x4 C[8], UA[10], UG[10];
              C[0] = *(const GAS f32x4*)(cb + f); C[1] = *(const GAS f32x4*)(cw + f); C[2] = *(const GAS f32x4*)(cw + 2 * D_FF + f); C[3] = *(const GAS f32x4*)(cw + 4 * D_FF + f);
              C[4] = *(const GAS f32x4*)(cb + D_FF + f); C[5] = *(const GAS f32x4*)(cw + D_FF + f); C[6] = *(const GAS f32x4*)(cw + 3 * D_FF + f); C[7] = *(const GAS f32x4*)(cw + 5 * D_FF + f);
              const bool hasp0 = inseq && ps != 0, hasn3 = inseq && ps != 3;
#pragma unroll
              for (int sidx = 0; sidx < 10; ++sidx) { const int slot = sidx - 1; const bool need = slot == -1 ? hasp0 : (slot == 8 ? hasn3 : true);
                  if (need) { UA[sidx] = *(const GAS f32x4*)(ub + (ptrdiff_t)slot * (ptrdiff_t)RW); UG[sidx] = *(const GAS f32x4*)(ub + (ptrdiff_t)slot * (ptrdiff_t)RW + D_FF); } else { UA[sidx] = z; UG[sidx] = z; } }
#pragma unroll
              for (int q = 0; q < 4; ++q) { const int sc = q == 0 ? 0 : (q == 1 ? 3 : (q == 2 ? 4 : 7)), t = q == 0 ? 0 : (q == 1 ? 127 : (q == 2 ? 128 : 255));
                  const f32x4 ca = C[0] + C[1] * UA[sc] + C[2] * UA[sc + 1] + C[3] * UA[sc + 2], cg = C[4] + C[5] * UG[sc] + C[6] * UG[sc + 1] + C[7] * UG[sc + 2];
                  *(GAS v2u*)(WSP(bf16, WS_ACT) + ((size_t)pm * 256 + t) * D_FF + f) = (v2u){pk2(silu_f(ca[0]) * cg[0], silu_f(ca[1]) * cg[1]), pk2(silu_f(ca[2]) * cg[2], silu_f(ca[3]) * cg[3])}; } } }
          VM_WAIT(); __syncthreads(); { unsigned o_ = 0; asm volatile("" : "+s"(o_)); lds = lds0 + o_; } }
        { epi::EpiOut<false> E{lds, l, 1, 0};
          GEMM(E, WSP(bf16, WS_ACT), D_FF, WSP(bf16, WS_WDN) + (size_t)l * D * D_FF, D_FF, M_ALL, D, D_FF); }
        GRID_BAR();
    }
    for (int rep_ = 0; rep_ < REP_BAR; ++rep_) GRID_BAR();
    { const int lane = LANE; f32x4 fg[4];
#pragma unroll
      for (int q = 0; q < 4; ++q) fg[q] = *(const GAS f32x4*)(final_gain + 256 * q + 4 * lane);
      for (i64 row0 = (i64)blockIdx.x * NWAVES + WAVE; row0 < M_ALL; row0 += (i64)4 * GSIZE * NWAVES) { v2u w[4][4]; f32x4 pq[4][4];
#pragma unroll
        for (int u = 0; u < 4; ++u) { const i64 row = row0 + (i64)u * GSIZE * NWAVES; const bf16* xr = WSP(bf16, WS_X) + (size_t)row * D;
#pragma unroll
            for (int q = 0; q < 4; ++q) { w[u][q] = *(const GAS v2u*)(xr + 256 * q + 4 * lane); pq[u][q] = *(const GAS f32x4*)(WSP(float, WS_SSQ) + (size_t)row * 16 + 4 * q); } }
#pragma unroll
        for (int u = 0; u < 4; ++u) { const i64 row = row0 + (i64)u * GSIZE * NWAVES; float* y = (row < M_CTX ? o_y_prompt + (size_t)row * D : o_y_sample + (size_t)(row - M_CTX) * D);
            const f32x4 sa = (pq[u][0] + pq[u][1]) + (pq[u][2] + pq[u][3]); const float rstd = __builtin_amdgcn_rsqf(((sa[0] + sa[1]) + (sa[2] + sa[3])) * (1.f / D) + EPS);
#pragma unroll
            for (int q = 0; q < 4; ++q) *(GAS f32x4*)(y + 256 * q + 4 * lane) = (f32x4){bflo(w[u][q].x), bfhi(w[u][q].x), bflo(w[u][q].y), bfhi(w[u][q].y)} * rstd * fg[q]; } } }
}

static int mk_launch(void* const* d_in, void* d_out, void* d_ws, size_t ws_size, hipStream_t stream) {
    static int grid = 0;
    if (grid == 0) {
        int dev = 0, cus = 0, per_cu = 0;
        if (hipGetDevice(&dev) != hipSuccess || hipDeviceGetAttribute(&cus, hipDeviceAttributeMultiprocessorCount, dev) != hipSuccess) { fprintf(stderr, "kernel_launch: device query failed\n"); grid = -1; return -1; }
        if (hipFuncSetAttribute((const void*)mk_fwd, hipFuncAttributeMaxDynamicSharedMemorySize, LDS_BYTES) != hipSuccess) { fprintf(stderr, "kernel_launch: hipFuncSetAttribute failed\n"); grid = -1; return -1; }
        if (hipOccupancyMaxActiveBlocksPerMultiprocessor(&per_cu, (const void*)mk_fwd, NTHR, LDS_BYTES) != hipSuccess || per_cu < 1) { fprintf(stderr, "kernel_launch: occupancy query says %d\n", per_cu); per_cu = 1; }
        (void)hipGetLastError();
        grid = cus;
        if (grid != 256) { fprintf(stderr, "kernel_launch: built for 256 CUs, found %d\n", cus); grid = -1; return -1; }
        if (ws_size < WS_END) { fprintf(stderr, "kernel_launch: workspace too small (%zu < %zu)\n", ws_size, (size_t)WS_END); grid = -1; return -1; }
    }
    if (grid < 0) return -1;
    (void)hipMemsetAsync((char*)d_ws + WS_CTL, 0, ZERO_BYTES, stream);
    Args a{};
    for (int i = 0; i < 30; ++i) a.in[i] = (const float*)d_in[i];
    a.out = (float*)d_out; a.ws = (unsigned char*)d_ws;
    void* kargs[] = {&a};
    hipError_t e = hipLaunchCooperativeKernel((const void*)mk_fwd, dim3(grid), dim3(NTHR), kargs, LDS_BYTES, stream);
    if (e != hipSuccess) { fprintf(stderr, "kernel_launch: cooperative launch failed: %s (grid %d)\n", hipGetErrorString(e), grid); return -1; }
    return 0;
}

extern "C" void kernel_launch(void* const* d_in, const int* in_sizes, int n_in, void* d_out, int out_size, void* d_ws, size_t ws_size, hipStream_t stream) {
    (void)in_sizes; (void)n_in; (void)out_size;
    mk_launch(d_in, d_out, d_ws, ws_size, stream);
}
```
